# Optimizing an MI355X kernel written in HIP

```python
import jax, jax.numpy as jnp
from jax import lax
import numpy as np

D_MODEL = 2048
BATCH = 8
SEQ = 4096
DEPTH = 1

N_HEADS_ATTN = 8
HEAD_DIM = 128
D_ATTN = N_HEADS_ATTN * HEAD_DIM
MOBA_BLOCK = 256
MOBA_TOPK = 3
Q_CHUNK = 16
ROPE_THETA = 500000.0
ROPE_DIM = HEAD_DIM // 4
N_GROUPS_SGU = 8
SGU_GROUP_DIM = 128
D_SGU = N_GROUPS_SGU * SGU_GROUP_DIM
SGU_CHUNK = 128
N_EXPERT_GROUPS = 4
EXPERTS_PER_GROUP = 8
N_EXPERTS = N_EXPERT_GROUPS * EXPERTS_PER_GROUP
D_FF_EXPERT = 1024
TOP_K_INNER = 2
DISPATCH_BLOCK = 256
EPS = 1e-6
D_IN_PROJ = 3 * D_ATTN + 2 * D_SGU + 2 * D_MODEL
SPLIT_POINTS = (D_ATTN, 2 * D_ATTN, 3 * D_ATTN, 3 * D_ATTN + D_SGU,
                3 * D_ATTN + 2 * D_SGU, 3 * D_ATTN + 2 * D_SGU + D_MODEL)

kernel_name = "hybrid_moba_sgu_hiermoe_block"


def rms_norm(x, g):
    xf = x.astype(jnp.float32)
    y = xf * lax.rsqrt(jnp.mean(xf * xf, axis=-1, keepdims=True) + EPS)
    return (y * g.astype(jnp.float32)).astype(x.dtype)


def layer_norm(x, g, b):
    xf = x.astype(jnp.float32)
    mu = jnp.mean(xf, axis=-1, keepdims=True)
    var = jnp.mean(jnp.square(xf - mu), axis=-1, keepdims=True)
    y = (xf - mu) * lax.rsqrt(var + EPS)
    return (y * g.astype(jnp.float32) + b.astype(jnp.float32)).astype(x.dtype)


def partial_rope(x, pos):
    half = ROPE_DIM // 2
    inv = ROPE_THETA ** (-jnp.arange(half, dtype=jnp.float32) * 2.0 / ROPE_DIM)
    ang = pos.astype(jnp.float32)[:, None] * inv[None, :]
    cos = jnp.cos(ang).astype(x.dtype)
    sin = jnp.sin(ang).astype(x.dtype)
    x1 = x[..., :half]
    x2 = x[..., half:ROPE_DIM]
    return jnp.concatenate([x1 * cos - x2 * sin, x2 * cos + x1 * sin, x[..., ROPE_DIM:]], axis=-1)


def moba_attention(q, k, v):
    B, S, H, dh = q.shape
    pos = jnp.arange(S)
    q = partial_rope(q.transpose(0, 2, 1, 3), pos)
    k = partial_rope(k.transpose(0, 2, 1, 3), pos)
    v = v.transpose(0, 2, 1, 3)
    n_blk = -(-S // MOBA_BLOCK)
    s_pad = n_blk * MOBA_BLOCK
    pad = ((0, 0), (0, 0), (0, s_pad - S), (0, 0))
    kb = jnp.pad(k, pad).reshape(B, H, n_blk, MOBA_BLOCK, dh)
    vb = jnp.pad(v, pad).reshape(B, H, n_blk, MOBA_BLOCK, dh)
    k_mean = jnp.mean(kb.astype(jnp.float32), axis=3).astype(k.dtype)
    k_eff = min(MOBA_TOPK, n_blk)
    n_sel = k_eff * MOBA_BLOCK
    scale = HEAD_DIM ** -0.5
    n_qc = S // Q_CHUNK
    q_chunks = q.reshape(B, H, n_qc, Q_CHUNK, dh).transpose(2, 0, 1, 3, 4)
    b_idx = jnp.arange(B)[:, None, None, None]
    h_idx = jnp.arange(H)[None, :, None, None]
    blk_ids = jnp.arange(n_blk)

    def chunk(args):
        qc, c = args
        q0 = c * Q_CHUNK
        blk = q0 // MOBA_BLOCK
        qpos = q0 + jnp.arange(Q_CHUNK)
        gate = jnp.einsum('bhqd,bhnd->bhqn', qc, k_mean).astype(jnp.float32)
        gate = jnp.where(blk_ids < blk, gate, -jnp.inf)
        _, sel = lax.top_k(gate, k_eff)
        valid = sel < blk
        k_sel = kb[b_idx, h_idx, sel]
        v_sel = vb[b_idx, h_idx, sel]
        s_sel = jnp.einsum('bhqd,bhqjkd->bhqjk', qc, k_sel).astype(jnp.float32) * scale
        s_sel = jnp.where(valid[..., None], s_sel, -jnp.inf).reshape(B, H, Q_CHUNK, n_sel)
        k_own = lax.dynamic_index_in_dim(kb, blk, axis=2, keepdims=False)
        v_own = lax.dynamic_index_in_dim(vb, blk, axis=2, keepdims=False)
        s_own = jnp.einsum('bhqd,bhkd->bhqk', qc, k_own).astype(jnp.float32) * scale
        kpos = blk * MOBA_BLOCK + jnp.arange(MOBA_BLOCK)
        s_own = jnp.where(kpos[None, :] <= qpos[:, None], s_own, -jnp.inf)
        p = jax.nn.softmax(jnp.concatenate([s_sel, s_own], axis=-1), axis=-1).astype(v.dtype)
        p_sel = p[..., :n_sel].reshape(B, H, Q_CHUNK, k_eff, MOBA_BLOCK)
        o = (jnp.einsum('bhqjk,bhqjkd->bhqd', p_sel, v_sel)
             + jnp.einsum('bhqk,bhkd->bhqd', p[..., n_sel:], v_own))
        return o

    out = lax.map(chunk, (q_chunks, jnp.arange(n_qc)))
    return out.transpose(1, 0, 3, 2, 4).reshape(B, S, H * dh)


def spatial_gating(u, vg, sgu_w, sgu_b, ln_g, ln_b):
    B, S, _ = u.shape
    u = jax.nn.gelu(u)
    vg = layer_norm(jax.nn.gelu(vg), ln_g, ln_b)
    n_ch = S // SGU_CHUNK
    vr = vg.reshape(B, n_ch, SGU_CHUNK, N_GROUPS_SGU, SGU_GROUP_DIM)
    causal = jnp.tril(jnp.ones((SGU_CHUNK, SGU_CHUNK), dtype=bool))
    w = jnp.where(causal[None], sgu_w, jnp.zeros_like(sgu_w))
    mixed = jnp.einsum('gts,bnsgc->bntgc', w, vr) + sgu_b.T[None, None, :, :, None]
    return u * mixed.reshape(B, S, D_SGU)


def hier_moe(h, w_rg, b_rg, w_re, b_re, w_gate, w_up, w_down):
    B, S, D = h.shape
    T = B * S
    xt = h.reshape(T, D)
    g_logits = (xt @ w_rg + b_rg).astype(jnp.float32)
    grp = jnp.argmax(g_logits, axis=-1)
    p_grp = jnp.take_along_axis(jax.nn.softmax(g_logits, axis=-1), grp[:, None], axis=-1)
    e_logits = (xt @ w_re + b_re).astype(jnp.float32).reshape(T, N_EXPERT_GROUPS, EXPERTS_PER_GROUP)
    e_logits = jnp.take_along_axis(e_logits, grp[:, None, None], axis=1)[:, 0]
    top_w, top_i = lax.top_k(jax.nn.softmax(e_logits, axis=-1), TOP_K_INNER)
    top_w = top_w / jnp.sum(top_w, axis=-1, keepdims=True)
    weights = p_grp * top_w
    experts = grp[:, None].astype(jnp.int32) * EXPERTS_PER_GROUP + top_i.astype(jnp.int32)

    n_assign = T * TOP_K_INNER
    flat_e = experts.reshape(n_assign)
    flat_w = weights.reshape(n_assign)
    flat_tok = jnp.repeat(jnp.arange(T, dtype=jnp.int32), TOP_K_INNER)
    order = jnp.argsort(flat_e)
    se = flat_e[order]
    counts = jax.ops.segment_sum(jnp.ones_like(flat_e), flat_e, num_segments=N_EXPERTS)
    padded = (counts + DISPATCH_BLOCK - 1) // DISPATCH_BLOCK * DISPATCH_BLOCK
    pad_end = jnp.cumsum(padded)
    pad_start = pad_end - padded
    start = jnp.cumsum(counts) - counts
    dest = pad_start[se] + jnp.arange(n_assign, dtype=jnp.int32) - start[se]
    n_rows = -(-n_assign // DISPATCH_BLOCK) * DISPATCH_BLOCK + N_EXPERTS * DISPATCH_BLOCK
    n_blocks = n_rows // DISPATCH_BLOCK
    row_tok = jnp.full((n_rows,), T, dtype=jnp.int32).at[dest].set(flat_tok[order])
    row_w = jnp.zeros((n_rows,), jnp.float32).at[dest].set(flat_w[order])
    blk_e = jnp.minimum(jnp.searchsorted(pad_end, jnp.arange(n_blocks) * DISPATCH_BLOCK, side='right'),
                        N_EXPERTS - 1).astype(jnp.int32)
    x_pad = jnp.concatenate([xt, jnp.zeros((1, D), xt.dtype)], axis=0)

    def expert_block(args):
        tok, e = args
        xb = x_pad[tok]
        hid = jax.nn.silu(xb @ w_gate[e]) * (xb @ w_up[e])
        return hid @ w_down[e]

    ys = lax.map(expert_block, (row_tok.reshape(n_blocks, DISPATCH_BLOCK), blk_e))
    ys = ys.reshape(n_rows, D) * row_w[:, None].astype(xt.dtype)
    out = jnp.zeros((T + 1, D), xt.dtype).at[row_tok].add(ys)
    return out[:T].reshape(B, S, D)


def hybrid_layer(x, norm_mix_g, w_in, sgu_w, sgu_b, sgu_ln_g, sgu_ln_b, w_proj_attn, w_proj_sgu,
                 w_out, norm_ffn_g, w_router_group, b_router_group, w_router_expert, b_router_expert,
                 w_exp_gate, w_exp_up, w_exp_down):
    B, S, _ = x.shape
    h = rms_norm(x, norm_mix_g)
    proj = h @ w_in
    q, k, v, u, vg, gate_attn, gate_sgu = jnp.split(proj, SPLIT_POINTS, axis=-1)
    shp = (B, S, N_HEADS_ATTN, HEAD_DIM)
    attn = moba_attention(q.reshape(shp), k.reshape(shp), v.reshape(shp))
    sgu = spatial_gating(u, vg, sgu_w, sgu_b, sgu_ln_g, sgu_ln_b)
    merged = (jax.nn.sigmoid(gate_attn) * (attn @ w_proj_attn)
              + jax.nn.sigmoid(gate_sgu) * (sgu @ w_proj_sgu))
    x = x + merged @ w_out
    x = x + hier_moe(rms_norm(x, norm_ffn_g), w_router_group, b_router_group, w_router_expert,
                     b_router_expert, w_exp_gate, w_exp_up, w_exp_down)
    return x


def setup_inputs(seed: int = 0) -> dict:
    key = jax.random.key(seed)
    ks = jax.random.split(key, 20)
    L = DEPTH

    def nrm(k, shape, scale):
        return jax.random.normal(k, shape, jnp.float32) * scale

    return {
        "x": nrm(ks[0], (BATCH, SEQ, D_MODEL), 1.0),
        "norm_mix_g": 1.0 + nrm(ks[1], (L, D_MODEL), 0.01),
        "w_in": nrm(ks[2], (L, D_MODEL, D_IN_PROJ), D_MODEL ** -0.5),
        "sgu_w": nrm(ks[3], (L, N_GROUPS_SGU, SGU_CHUNK, SGU_CHUNK), SGU_CHUNK ** -0.5),
        "sgu_b": 1.0 + nrm(ks[4], (L, N_GROUPS_SGU, SGU_CHUNK), 0.01),
        "sgu_ln_g": 1.0 + nrm(ks[5], (L, D_SGU), 0.01),
        "sgu_ln_b": nrm(ks[6], (L, D_SGU), 0.01),
        "w_proj_attn": nrm(ks[7], (L, D_ATTN, D_MODEL), D_ATTN ** -0.5),
        "w_proj_sgu": nrm(ks[8], (L, D_SGU, D_MODEL), D_SGU ** -0.5),
        "w_out": nrm(ks[9], (L, D_MODEL, D_MODEL), D_MODEL ** -0.5),
        "norm_ffn_g": 1.0 + nrm(ks[10], (L, D_MODEL), 0.01),
        "w_router_group": nrm(ks[11], (L, D_MODEL, N_EXPERT_GROUPS), D_MODEL ** -0.5),
        "b_router_group": nrm(ks[12], (L, N_EXPERT_GROUPS), 0.01),
        "w_router_expert": nrm(ks[13], (L, D_MODEL, N_EXPERTS), D_MODEL ** -0.5),
        "b_router_expert": nrm(ks[14], (L, N_EXPERTS), 0.01),
        "w_exp_gate": nrm(ks[15], (L, N_EXPERTS, D_MODEL, D_FF_EXPERT), D_MODEL ** -0.5),
        "w_exp_up": nrm(ks[16], (L, N_EXPERTS, D_MODEL, D_FF_EXPERT), D_MODEL ** -0.5),
        "w_exp_down": nrm(ks[17], (L, N_EXPERTS, D_FF_EXPERT, D_MODEL), D_FF_EXPERT ** -0.5),
        "norm_final_g": 1.0 + nrm(ks[18], (D_MODEL,), 0.01),
    }


def reference(x, norm_mix_g, w_in, sgu_w, sgu_b, sgu_ln_g, sgu_ln_b, w_proj_attn, w_proj_sgu,
              w_out, norm_ffn_g, w_router_group, b_router_group, w_router_expert, b_router_expert,
              w_exp_gate, w_exp_up, w_exp_down, norm_final_g):
    for l in range(DEPTH):
        x = hybrid_layer(x, norm_mix_g[l], w_in[l], sgu_w[l], sgu_b[l], sgu_ln_g[l], sgu_ln_b[l],
                         w_proj_attn[l], w_proj_sgu[l], w_out[l], norm_ffn_g[l],
                         w_router_group[l], b_router_group[l], w_router_expert[l], b_router_expert[l],
                         w_exp_gate[l], w_exp_up[l], w_exp_down[l])
    return rms_norm(x, norm_final_g)
```

```cpp
#include <hip/hip_runtime.h>
#include <cstdio>
#include <cstdint>
#include <cstddef>

#ifndef REP_GEMM
#define REP_GEMM 0
#endif
#ifndef REP_MOE
#define REP_MOE 1
#endif
#ifndef REP_ATT
#define REP_ATT 1
#endif
#ifndef REP_SGU
#define REP_SGU 1
#endif
#ifndef REP_P7
#define REP_P7 1
#endif
#ifndef REP_P0
#define REP_P0 1
#endif
#ifndef REP_P12
#define REP_P12 1
#endif
#ifndef REP_A2
#define REP_A2 1
#endif
#ifndef ATT_CLAMP
#define ATT_CLAMP 0
#endif
#ifndef ATT_SUB
#define ATT_SUB 2
#endif
#ifndef ATT_STAGE
#define ATT_STAGE 3
#endif
#ifndef NT8
#define NT8 28
#endif
#ifndef MK_N_LAUNCHES
#define MK_N_LAUNCHES 1
#endif

#define LAS __attribute__((address_space(3)))
#define GAS __attribute__((address_space(1)))
typedef unsigned short bf16_t;
typedef short bf16x8 __attribute__((ext_vector_type(8)));
typedef short s16x4 __attribute__((ext_vector_type(4)));
typedef float f32x4 __attribute__((ext_vector_type(4)));
typedef float f32x2 __attribute__((ext_vector_type(2)));
typedef float f32x16 __attribute__((ext_vector_type(16)));
typedef unsigned u32x4 __attribute__((ext_vector_type(4)));
typedef unsigned u32x2 __attribute__((ext_vector_type(2)));

constexpr int BATCH = 8, SEQ = 4096, DM = 2048, T = BATCH * SEQ;
constexpr int NH = 8, HD = 128, DA = 1024, DS = 1024, NPROJ = 9216;
constexpr int MOBA_BLK = 256, NBLK = SEQ / MOBA_BLK;
constexpr int SGU_CHUNK = 128, SGU_G = 8;
constexpr int NE = 32, NEG = 4, EPG = 8, FF = 1024, NASSIGN = 2 * T;
constexpr int MAXRB = NASSIGN / 256 + NE;
constexpr float EPS = 1e-6f;

__device__ __forceinline__ unsigned cvt_pk_bf16(float lo, float hi) { unsigned r; asm volatile("v_cvt_pk_bf16_f32 %0, %1, %2" : "=v"(r) : "v"(lo), "v"(hi)); return r; }
__device__ __forceinline__ float bf_lo(unsigned w) { return __uint_as_float(w << 16); }
__device__ __forceinline__ float bf_hi(unsigned w) { return __uint_as_float(w & 0xffff0000u); }
__device__ __forceinline__ float sigmoid_f(float x) { return __builtin_amdgcn_rcpf(1.0f + __builtin_amdgcn_exp2f(-1.4426950408889634f * x)); }
__device__ __forceinline__ float gelu_tanh_f(float x) { const float y = 1.5957691216057308f * (x + 0.044715f * x * x * x); return x * sigmoid_f(y); }
__device__ __forceinline__ float silu_f(float x) { return x * sigmoid_f(x); }

namespace pg8 {
constexpr int BM = 256, BK = 64, HALF = 128, HTB = HALF * BK * 2  , STAGE_BYTES = 8 * HTB;
__host__ __device__ __forceinline__ int lds_byte(int r, int c) { const int st = (r >> 4) * 2 + (c >> 5), rr = r & 15, cc = c & 31, ob = rr * 64 + cc * 2; return st * 1024 + (ob ^ (((ob >> 9) & 1) << 5)); }
__host__ __device__ __forceinline__ void stage_rc(int b, int& R, int& C) { const int st = b / 1024, sb = b % 1024, swz = sb ^ (((sb >> 9) & 1) << 5); R = (st >> 1) * 16 + swz / 64; C = (st & 1) * 32 + (swz % 64) / 2; }
__host__ __device__ __forceinline__ int perm32(int rho) { const int n = rho >> 4, i = rho & 15; return 8 * (i >> 2) + 4 * n + (i & 3); }

typedef int i32x8 __attribute__((ext_vector_type(8)));
typedef int i32x4 __attribute__((ext_vector_type(4)));
__device__ __forceinline__ i32x8 cat8(bf16x8 a, bf16x8 b) { return __builtin_shufflevector(__builtin_bit_cast(i32x4, a), __builtin_bit_cast(i32x4, b), 0, 1, 2, 3, 4, 5, 6, 7); }
struct Unit { int pm, pn; const char* A; const char* B; int x0, x1, x2; };

template <class Epi, class Sched, bool ALIGN_EPI, bool SP2, bool FP8 = false>
__device__ __forceinline__ void gemm_phase(LAS unsigned char* lds, const int K, const Sched& S, const Epi& E, const int tid) {
    const int wid = __builtin_amdgcn_readfirstlane(tid >> 6), lane = tid & 63, wr = wid >> 2, wc = wid & 3, fr = lane & 15, fq = lane >> 4;
    const int nt = K / BK;
    constexpr bool GATHER = Sched::GATHER;
    unsigned vA[2][2], voffB[2]; int RA[2], CA[2];
#pragma unroll
    for (int i = 0; i < 2; ++i) { int R, C; stage_rc(tid * 16 + i * 8192, R, C); const int Rb = Epi::PERM ? ((R & ~31) + perm32(R & 31)) : R;
        RA[i] = R; CA[i] = C * 2; voffB[i] = (unsigned)(Rb * K + C) * 2u;
        vA[0][i] = (unsigned)(R * K + C) * 2u; vA[1][i] = (unsigned)((R + HALF) * K + C) * 2u; }
    const size_t kstep = (size_t)(BK * 2);
    const size_t hstep = (size_t)HALF * K * 2;
    const unsigned ldsw = (unsigned)wid * 1024u;
    const int aoff = lds_byte(wr * 64 + fr, fq * 8), boff = lds_byte(wc * 32 + fr, fq * 8);
#define PG8_SA(b, h) (((b) * 2 + (h)) * HTB)
#define PG8_SB(b, h) ((4 + (b) * 2 + (h)) * HTB)
#define PG8_STAGE(bufoff, gbase, voff) do { _Pragma("unroll") for (int _i = 0; _i < 2; ++_i) \
        __builtin_amdgcn_global_load_lds((const unsigned*)((const char*)(gbase) + (voff)[_i]), (LAS unsigned*)(lds + (bufoff) + ldsw + _i * 8192), 16, 0, 0); } while (0)
#define PG8_LDA(dst, b, h) do { _Pragma("unroll") for (int m = 0; m < 4; ++m) _Pragma("unroll") for (int k = 0; k < 2; ++k) dst[m][k] = *(const LAS bf16x8*)(lds + PG8_SA(b, h) + aoff + m * 2048 + k * 1024); } while (0)
#define PG8_LDB(dst, b, h) do { _Pragma("unroll") for (int n = 0; n < 2; ++n) _Pragma("unroll") for (int k = 0; k < 2; ++k) dst[n][k] = *(const LAS bf16x8*)(lds + PG8_SB(b, h) + boff + n * 2048 + k * 1024); } while (0)
#define PG8_MMA(ai, bj, At, Bt) do { __builtin_amdgcn_s_setprio(1); _Pragma("unroll") for (int m = 0; m < 4; ++m) _Pragma("unroll") for (int n = 0; n < 2; ++n) { \
        if constexpr (FP8) { asm volatile("v_mfma_scale_f32_16x16x128_f8f6f4 %0, %1, %2, %0, %3, %4 op_sel_hi:[0,0,0]" : "+v"(acc[ai][bj][m][n]) : "v"(cat8(Bt[n][0], Bt[n][1])), "v"(cat8(At[m][0], At[m][1])), "v"(sc_w), "v"(sc_a)); } \
        else { _Pragma("unroll") for (int k = 0; k < 2; ++k) acc[ai][bj][m][n] = __builtin_amdgcn_mfma_f32_16x16x32_bf16(Bt[n][k], At[m][k], acc[ai][bj][m][n], 0, 0, 0); } } __builtin_amdgcn_s_setprio(0); } while (0)
#define PG8_WAIT_V(n) asm volatile("s_waitcnt vmcnt(" #n ")" ::: "memory")
#define PG8_WAIT_L(n) asm volatile("s_waitcnt lgkmcnt(" #n ")" ::: "memory")
#define PG8_BAR __builtin_amdgcn_s_barrier()
#define PG8_SCHED __builtin_amdgcn_sched_barrier(0)
    Unit cur, nxt; int ui = 0;
    if (!S.next(0, cur)) return;
    f32x4 acc[2][2][4][2];
#pragma unroll
    for (int a = 0; a < 2; ++a)
#pragma unroll
        for (int b = 0; b < 2; ++b)
#pragma unroll
            for (int m = 0; m < 4; ++m)
#pragma unroll
                for (int n = 0; n < 2; ++n) acc[a][b][m][n] = (f32x4){0.f, 0.f, 0.f, 0.f};
    bf16x8 At[4][2], B0[2][2], B1[2][2];
    int sc_w = 0x7A7A7A7A, sc_a = 0x7F7F7F7F;
    if constexpr (FP8) asm volatile("" : "+v"(sc_w), "+v"(sc_a));
    const char* cA = cur.A; const char* cB = cur.B;
    if constexpr (GATHER) {
#pragma unroll
        for (int h = 0; h < 2; ++h)
#pragma unroll
            for (int i = 0; i < 2; ++i) vA[h][i] = S.row_off(cur, 0, h * HALF + RA[i]) + (unsigned)CA[i];
    }
    if constexpr (SP2) {
        PG8_STAGE(PG8_SB(0, 0), cB, voffB); PG8_STAGE(PG8_SB(0, 1), cB + hstep, voffB); PG8_STAGE(PG8_SA(0, 0), cA, vA[0]); PG8_STAGE(PG8_SA(0, 1), cA, vA[1]);
        if (wr == 1) PG8_BAR;
        PG8_WAIT_V(2); PG8_BAR;
        PG8_STAGE(PG8_SB(1, 0), cB + kstep, voffB); PG8_STAGE(PG8_SA(1, 0), cA + kstep, vA[0]); PG8_STAGE(PG8_SB(1, 1), cB + hstep + kstep, voffB);
        PG8_WAIT_V(6); PG8_BAR;
    } else {
        PG8_STAGE(PG8_SB(0, 0), cB, voffB); PG8_STAGE(PG8_SA(0, 0), cA, vA[0]); PG8_STAGE(PG8_SB(0, 1), cB + hstep, voffB); PG8_STAGE(PG8_SA(0, 1), cA, vA[1]);
        if (wr == 1) PG8_BAR;
        PG8_WAIT_V(4); PG8_BAR;
        PG8_STAGE(PG8_SB(1, 0), cB + kstep, voffB); PG8_STAGE(PG8_SA(1, 0), cA + kstep, vA[0]); PG8_STAGE(PG8_SB(1, 1), cB + hstep + kstep, voffB);
        PG8_WAIT_V(6); PG8_BAR;
    }
    for (;;) {
        const bool has_next = S.next(ui + 1, nxt);
        const char* nA = has_next ? nxt.A : cA; const char* nB = has_next ? nxt.B : cB;
        for (int t = 0; t < nt; t += 2) {
            const bool last = (t == nt - 2);
            const char* a1 = cA + (size_t)(t + 1) * kstep;
            const char* a2 = last ? nA : cA + (size_t)(t + 2) * kstep; const char* b2 = last ? nB : cB + (size_t)(t + 2) * kstep;
            const char* a3 = a2 + kstep; const char* b3 = b2 + kstep;
            unsigned vNx[2][2];
            if constexpr (GATHER) {
                if (last && has_next) { int t2 = tid; asm volatile("" : "+v"(t2));
#pragma unroll
                    for (int i = 0; i < 2; ++i) { int R2, C2; stage_rc(t2 * 16 + i * 8192, R2, C2);
#pragma unroll
                        for (int h = 0; h < 2; ++h) vNx[h][i] = S.row_off(nxt, ui + 1, h * HALF + R2) + (unsigned)(C2 * 2); }
                }
            }
#define PG8_SWITCH() do { if constexpr (GATHER) { if (last && has_next) { _Pragma("unroll") for (int h = 0; h < 2; ++h) _Pragma("unroll") for (int i = 0; i < 2; ++i) vA[h][i] = vNx[h][i]; } } } while (0)
            if constexpr (SP2) {
            PG8_LDB(B0, 0, 0); PG8_LDB(B1, 0, 1); PG8_SCHED; PG8_LDA(At, 0, 0); PG8_STAGE(PG8_SA(1, 1), a1, vA[1]); PG8_SWITCH();
            PG8_WAIT_V(8); PG8_WAIT_L(0); PG8_BAR; PG8_MMA(0, 0, At, B0); PG8_MMA(0, 1, At, B1); PG8_BAR; PG8_SCHED;
            PG8_LDA(At, 0, 1); PG8_STAGE(PG8_SB(0, 0), b2, voffB); PG8_STAGE(PG8_SB(0, 1), b2 + hstep, voffB); PG8_STAGE(PG8_SA(0, 0), a2, vA[0]);
            PG8_WAIT_V(8); PG8_WAIT_L(0); PG8_BAR; PG8_MMA(1, 0, At, B0); PG8_MMA(1, 1, At, B1); PG8_BAR; PG8_SCHED;
            PG8_LDB(B0, 1, 0); PG8_LDB(B1, 1, 1); PG8_SCHED; PG8_LDA(At, 1, 0); PG8_STAGE(PG8_SA(0, 1), a2, vA[1]);
            PG8_WAIT_V(8); PG8_WAIT_L(0); PG8_BAR; PG8_MMA(0, 0, At, B0); PG8_MMA(0, 1, At, B1); PG8_BAR; PG8_SCHED;
            PG8_LDA(At, 1, 1); PG8_STAGE(PG8_SB(1, 0), b3, voffB); PG8_STAGE(PG8_SB(1, 1), b3 + hstep, voffB); PG8_STAGE(PG8_SA(1, 0), a3, vA[0]);
            PG8_WAIT_V(8); PG8_WAIT_L(0); PG8_BAR; PG8_MMA(1, 0, At, B0); PG8_MMA(1, 1, At, B1); PG8_BAR; PG8_SCHED;
            } else {
            PG8_LDB(B0, 0, 0); PG8_SCHED; PG8_LDA(At, 0, 0); PG8_STAGE(PG8_SA(1, 1), a1, vA[1]); PG8_SWITCH();
            PG8_WAIT_L(8); PG8_BAR; PG8_WAIT_L(0); PG8_MMA(0, 0, At, B0); PG8_BAR; PG8_SCHED;
            PG8_LDB(B1, 0, 1); PG8_STAGE(PG8_SB(0, 0), b2, voffB);
            PG8_BAR; PG8_WAIT_L(0); PG8_MMA(0, 1, At, B1); PG8_BAR;
            PG8_LDA(At, 0, 1); PG8_STAGE(PG8_SA(0, 0), a2, vA[0]);
            PG8_BAR; PG8_WAIT_L(0); PG8_MMA(1, 0, At, B0); PG8_BAR; PG8_SCHED;
            PG8_STAGE(PG8_SB(0, 1), b2 + hstep, voffB);
            PG8_WAIT_V(6); PG8_BAR; PG8_MMA(1, 1, At, B1); PG8_BAR;
            PG8_LDB(B0, 1, 0); PG8_SCHED; PG8_LDA(At, 1, 0); PG8_STAGE(PG8_SA(0, 1), a2, vA[1]);
            PG8_WAIT_L(8); PG8_BAR; PG8_WAIT_L(0); PG8_MMA(0, 0, At, B0); PG8_BAR; PG8_SCHED;
            PG8_LDB(B1, 1, 1); PG8_STAGE(PG8_SB(1, 0), b3, voffB);
            PG8_BAR; PG8_WAIT_L(0); PG8_MMA(0, 1, At, B1); PG8_BAR;
            PG8_LDA(At, 1, 1); PG8_STAGE(PG8_SA(1, 0), a3, vA[0]);
            PG8_BAR; PG8_WAIT_L(0); PG8_MMA(1, 0, At, B0); PG8_BAR; PG8_SCHED;
            PG8_STAGE(PG8_SB(1, 1), b3 + hstep, voffB);
            PG8_WAIT_V(6); PG8_BAR; PG8_MMA(1, 1, At, B1); PG8_BAR;
            }
        }
        if constexpr (ALIGN_EPI) { if (wr == 0) PG8_BAR; }
        if constexpr (FP8) asm volatile("s_nop 15\n\ts_nop 15" ::: "memory");
        E(acc, cur, wr, wc, fr, fq);
        if (!has_next) break;
#pragma unroll
        for (int a = 0; a < 2; ++a)
#pragma unroll
            for (int b = 0; b < 2; ++b)
#pragma unroll
                for (int m = 0; m < 4; ++m)
#pragma unroll
                    for (int n = 0; n < 2; ++n) acc[a][b][m][n] = (f32x4){0.f, 0.f, 0.f, 0.f};
        cur = nxt; cA = nA; cB = nB; ++ui;
        if constexpr (ALIGN_EPI) { if (wr == 1) PG8_BAR; }
    }
    PG8_WAIT_V(0);
    if constexpr (!ALIGN_EPI) { if (wr == 0) PG8_BAR; }
    PG8_BAR;
#undef PG8_SA
#undef PG8_SB
#undef PG8_STAGE
#undef PG8_LDA
#undef PG8_LDB
#undef PG8_MMA
#undef PG8_WAIT_V
#undef PG8_WAIT_L
#undef PG8_BAR
#undef PG8_SCHED
#undef PG8_SWITCH
}

constexpr int NXCD = 8, WGM = 8;
struct DenseOrder {
    static constexpr bool GATHER = false;
    const char* A; const char* Bt; int K, nM, nN, nwg, G, c, reps, skip_from, skip_len;
    __device__ __forceinline__ void init(const void* A_, const void* Bt_, int M, int N, int K_, int G_, int c_, int reps_ = 1, int skip_from_ = 1 << 20, int skip_len_ = 0) { A = (const char*)A_; Bt = (const char*)Bt_; K = K_; nM = M / BM; nN = N / BM; nwg = nM * nN; G = G_; c = c_; reps = reps_; skip_from = skip_from_; skip_len = skip_len_; }
    __device__ __forceinline__ bool next(int i, Unit& u) const {
        const long L = (long)i * G + c; if (L >= (long)nwg * reps) return false;
        int wgid = (int)(L % nwg); { const int q = nwg / NXCD, r = nwg % NXCD, xcd = wgid % NXCD, off = wgid / NXCD; wgid = (xcd < r ? xcd * (q + 1) : r * (q + 1) + (xcd - r) * q) + off; }
        const int nig = WGM * nN, gid = wgid / nig, fm = gid * WGM, gsz = (nM - fm) < WGM ? (nM - fm) : WGM;
        u.pm = fm + ((wgid % nig) % gsz); u.pn = (wgid % nig) / gsz; if (u.pn >= skip_from) u.pn += skip_len;
        u.A = A + (size_t)u.pm * BM * K * 2; u.B = Bt + (size_t)u.pn * BM * K * 2; u.x0 = 0; u.x1 = 0; u.x2 = (L >= nwg) ? 1 : 0; return true;
    }
    __device__ __forceinline__ unsigned row_off(const Unit&, int, int) const { return 0u; }
};
}

namespace att {
constexpr int D = 128, LD = 1024, NW = 8, QBLK = 32, KVBLK = 64, QB = 256;
constexpr int SHM_V = KVBLK * D * 2, SHM_K = KVBLK * D * 2;
constexpr int LDS_BYTES = 2 * SHM_V + 2 * SHM_K + NW * 64 * 4;
constexpr float SCALE = 0.08838834764831845f, THR = 8.f;
#define KSWZ(row, colB) ((((colB) >> 7) * 8192) + (row) * 128 + (((colB) & 127) ^ (((((row) >> 1) & 1) | ((((row) >> 3) & 3) << 1)) << 4)))
#define KROW32 (32 * 128)
#define SBAR() __builtin_amdgcn_sched_barrier(0)
__device__ __forceinline__ int v_st(int k, int c) { const int kk = (k & ~0xC) | ((k & 4) << 1) | ((k & 8) >> 1); return ((kk >> 3) * 4 + (c >> 5)) * 512 + ((kk & 7) * 32 + (c & 31)) * 2; }
__device__ __forceinline__ int v_rd_base(int lane) { return ((lane & 3) << 3) | (((lane >> 2) & 3) << 6) | (((lane >> 4) & 1) << 5) | (((lane >> 5) & 1) << 8); }
constexpr int v_rd_off(int d0, int ks, int half) { return d0 * 512 + ks * 4096 + half * 2048; }
__device__ __forceinline__ int crow(int r, int hi) { return (r & 3) + 8 * (r >> 2) + 4 * hi; }
__device__ __forceinline__ bf16x8 load8(const bf16_t* p) { return *reinterpret_cast<const bf16x8*>(p); }
__device__ __forceinline__ void mask_causal(f32x16& p0, f32x16& p1, int dq) {
    const float NEG = -__builtin_inff();
#pragma unroll
    for (int r = 0; r < 16; ++r) { const int c = (r & 3) + 8 * (r >> 2); if (dq - c < 0) p0[r] = NEG; if (dq - c - 32 < 0) p1[r] = NEG; }
}
__device__ __forceinline__ void mask_all(f32x16& p0, f32x16& p1, bool keep) {
    const float NEG = -__builtin_inff();
#pragma unroll
    for (int r = 0; r < 16; ++r) { p0[r] = keep ? p0[r] : NEG; p1[r] = keep ? p1[r] : NEG; }
}
__device__ __forceinline__ void partialSM(f32x16& p0, f32x16& p1, float& m_reg, float& mn, float& alpha) {
    float pmax = p0[0];
#pragma unroll
    for (int r = 1; r < 16; ++r) pmax = fmaxf(pmax, p0[r]);
#pragma unroll
    for (int r = 0; r < 16; ++r) pmax = fmaxf(pmax, p1[r]);
    { auto rr = __builtin_amdgcn_permlane32_swap(__float_as_uint(pmax), __float_as_uint(pmax), false, false);
      pmax = fmaxf(__uint_as_float(rr[0]), __uint_as_float(rr[1])); }
    constexpr float C2 = 1.4426950408889634f * SCALE;
    if (__builtin_expect(__all((pmax - m_reg) * SCALE <= THR), 1)) { mn = m_reg; alpha = 1.f; }
    else { mn = fmaxf(m_reg, pmax); alpha = __builtin_amdgcn_exp2f((m_reg - mn) * C2); m_reg = mn; }
    const float mnL = -mn * C2;
#pragma unroll
    for (int r = 0; r < 16; ++r) p0[r] = fmaf(p0[r], C2, mnL);
#pragma unroll
    for (int r = 0; r < 16; ++r) p1[r] = fmaf(p1[r], C2, mnL);
#pragma unroll
    for (int r = 0; r < 16; ++r) p0[r] = __builtin_amdgcn_exp2f(p0[r]);
}
__device__ __forceinline__ void finishSM(f32x16& p0, f32x16& p1, float alpha, float& l_reg, bf16x8& pa0, bf16x8& pa1, bf16x8& pa2, bf16x8& pa3) {
#pragma unroll
    for (int r = 0; r < 16; ++r) p1[r] = __builtin_amdgcn_exp2f(p1[r]);
    float ps = 0;
#pragma unroll
    for (int r = 0; r < 16; ++r) ps += p0[r];
#pragma unroll
    for (int r = 0; r < 16; ++r) ps += p1[r];
    { auto rr = __builtin_amdgcn_permlane32_swap(__float_as_uint(ps), __float_as_uint(ps), false, false);
      ps = __uint_as_float(rr[0]) + __uint_as_float(rr[1]); }
    l_reg = l_reg * alpha + ps;
#define PK4(P, B_, OUT) do { unsigned a0 = cvt_pk_bf16(P[B_+0], P[B_+1]), a1 = cvt_pk_bf16(P[B_+2], P[B_+3]);                          \
        unsigned b0 = cvt_pk_bf16(P[B_+4], P[B_+5]), b1 = cvt_pk_bf16(P[B_+6], P[B_+7]);                                             \
        auto r0 = __builtin_amdgcn_permlane32_swap(a0, b0, false, false); auto r1 = __builtin_amdgcn_permlane32_swap(a1, b1, false, false); \
        u32x4 w = {r0[0], r1[0], r0[1], r1[1]}; OUT = *reinterpret_cast<bf16x8*>(&w); } while (0)
    PK4(p0, 0, pa0); PK4(p0, 8, pa1); PK4(p1, 0, pa2); PK4(p1, 8, pa3);
#undef PK4
}
template <int KB>
__device__ __forceinline__ void qkt(f32x16& p0, f32x16& p1, const char* K_lds, int r32, int hi, const bf16x8* qr) {
    p0 = f32x16{}; p1 = f32x16{};
    const char* kb[4];
#pragma unroll
    for (int dd = 0; dd < 4; ++dd) kb[dd] = K_lds + KB * SHM_K + KSWZ(r32, (dd * 16 + hi * 8) * 2);
#pragma unroll
    for (int d0 = 0; d0 < 8; ++d0) { const char* a = kb[d0 & 3] + (d0 >> 2) * 8192;
        bf16x8 b0 = *reinterpret_cast<const bf16x8*>(a);
        bf16x8 b1 = *reinterpret_cast<const bf16x8*>(a + KROW32);
        p0 = __builtin_amdgcn_mfma_f32_32x32x16_bf16(b0, qr[d0], p0, 0, 0, 0);
        p1 = __builtin_amdgcn_mfma_f32_32x32x16_bf16(b1, qr[d0], p1, 0, 0, 0); }
}
template <int VB>
__device__ __forceinline__ void pv_tile(f32x16* o, int vb0, bf16x8 pa0, bf16x8 pa1, bf16x8 pa2, bf16x8 pa3) {
#define TRRD(dst, off) asm volatile("ds_read_b64_tr_b16 %0, %1 offset:%2" : "=&v"(dst) : "v"(vb0), "i"(off) : "memory")
#define PV_RD(S_, d0) do { constexpr int b_ = VB * SHM_V + v_rd_off(d0, 0, 0); \
        TRRD(S_[0], b_); TRRD(S_[1], b_ + 2048); TRRD(S_[2], b_ + 4096); TRRD(S_[3], b_ + 6144); TRRD(S_[4], b_ + 8192); TRRD(S_[5], b_ + 10240); TRRD(S_[6], b_ + 12288); TRRD(S_[7], b_ + 14336); } while (0)
#define PV_MF(S_, d0) do { \
        o[d0] = __builtin_amdgcn_mfma_f32_32x32x16_bf16(pa0, (bf16x8){S_[0][0], S_[0][1], S_[0][2], S_[0][3], S_[1][0], S_[1][1], S_[1][2], S_[1][3]}, o[d0], 0, 0, 0);   \
        o[d0] = __builtin_amdgcn_mfma_f32_32x32x16_bf16(pa1, (bf16x8){S_[2][0], S_[2][1], S_[2][2], S_[2][3], S_[3][0], S_[3][1], S_[3][2], S_[3][3]}, o[d0], 0, 0, 0);   \
        o[d0] = __builtin_amdgcn_mfma_f32_32x32x16_bf16(pa2, (bf16x8){S_[4][0], S_[4][1], S_[4][2], S_[4][3], S_[5][0], S_[5][1], S_[5][2], S_[5][3]}, o[d0], 0, 0, 0);   \
        o[d0] = __builtin_amdgcn_mfma_f32_32x32x16_bf16(pa3, (bf16x8){S_[6][0], S_[6][1], S_[6][2], S_[6][3], S_[7][0], S_[7][1], S_[7][2], S_[7][3]}, o[d0], 0, 0, 0); } while (0)
    s16x4 fa[8], fb[8];
    PV_RD(fa, 0);
    PV_RD(fb, 1); asm volatile("s_waitcnt lgkmcnt(8)" ::: "memory"); SBAR(); PV_MF(fa, 0); SBAR();
    PV_RD(fa, 2); asm volatile("s_waitcnt lgkmcnt(8)" ::: "memory"); SBAR(); PV_MF(fb, 1); SBAR();
    PV_RD(fb, 3); asm volatile("s_waitcnt lgkmcnt(8)" ::: "memory"); SBAR(); PV_MF(fa, 2); SBAR();
    asm volatile("s_waitcnt lgkmcnt(0)" ::: "memory"); SBAR(); PV_MF(fb, 3);
#undef PV_RD
#undef PV_MF
#undef TRRD
}
constexpr int WS_OFF = 2 * SHM_V + 2 * SHM_K;
constexpr int OST_OFF = WS_OFF + NW * 1024;
constexpr int LDS_BYTES2 = OST_OFF + NW * 8192;
constexpr int LCAP = 3840;
struct URef { unsigned qoff, koff; int key0; unsigned lbase; int rows; unsigned pbase; };
struct Bases { unsigned char* wsb; unsigned oQ, oK, oV, oO, oPART, oPML, oALIST; };
struct Seam { bf16x8 qr[8]; bf16x8 st_v0, st_v1, st_k0, st_k1; unsigned ent; };
#define LDG8(boff) (*(const bf16x8*)(BS.wsb + (ATT_CLAMP ? (((boff) < 0x3C000000u) ? (boff) : 0x3C000000u) : (boff))))
#define VMW() asm volatile("s_waitcnt vmcnt(0)" ::: "memory")
#define VMWN(n) asm volatile("s_waitcnt vmcnt(%0)" :: "i"(n) : "memory")
#define SLOAD_H(koff_, k0) do { const unsigned ko_ = ((koff_) + (unsigned)(k0) * LD) * 2u;     \
                         S.st_v0 = LDG8(BS.oV + ko_ + kl0); S.st_v1 = LDG8(BS.oV + ko_ + kl1); S.st_k0 = LDG8(BS.oK + ko_ + kl0); S.st_k1 = LDG8(BS.oK + ko_ + kl1); } while (0)
#define SWRITE_HK(bf) do { *(bf16x8*)(K_lds + (bf) * SHM_K + kws) = S.st_k0; *(bf16x8*)(K_lds + (bf) * SHM_K + kws + KROW32) = S.st_k1; } while (0)
#define SWRITE_HV(bf) do { *(bf16x8*)(V_lds + (bf) * SHM_V + vst0) = S.st_v0; *(bf16x8*)(V_lds + (bf) * SHM_V + vst1) = S.st_v1; } while (0)
#define SWRITE_H(bf) do { SWRITE_HV(bf); SWRITE_HK(bf); } while (0)
template <int MODE> __device__ __forceinline__ void q_loads(const Bases& BS, const URef& u, Seam& S, int wid, int r32, int hi) {
    unsigned ql;
    if constexpr (MODE == 1) { int row = wid * QBLK + r32; row = row < u.rows ? row : u.rows - 1; S.ent = *(const unsigned short*)(BS.wsb + (BS.oALIST + (ATT_CLAMP ? ((u.lbase + (unsigned)row) & 0x3FFFFFu) : (u.lbase + (unsigned)row)) * 2u)); ql = (unsigned)((S.ent & 4095u) * LD + hi * 8) * 2u; }
    else ql = (unsigned)((wid * QBLK + r32) * LD + hi * 8) * 2u;
    const unsigned qb_ = BS.oQ + u.qoff * 2u + ql;
#pragma unroll
    for (int d0 = 0; d0 < 8; ++d0) S.qr[d0] = LDG8(qb_ + d0 * 32);
}
template <int MODE> __device__ __forceinline__ void prime(const Bases& BS, const URef& cur, char* lds, Seam& S, const int tid) {
    const int wid = __builtin_amdgcn_readfirstlane(tid >> 6), lane = tid & 63, r32 = lane & 31, hi = lane >> 5;
    const int sr = tid >> 4, sc = (tid & 15) * 8, kws = KSWZ(sr, sc * 2); char* K_lds = lds + 2 * SHM_V;
    const unsigned kl0 = (unsigned)(sr * LD + sc) * 2u, kl1 = kl0 + 32u * LD * 2u;
    q_loads<MODE>(BS, cur, S, wid, r32, hi);
    SLOAD_H(cur.koff, cur.key0); VMW(); SWRITE_HK(0);
    __syncthreads();
}
__device__ __forceinline__ unsigned moba_select(const bf16x8* qr, const bf16_t* KM, int bq, int r32, int hi) {
    f32x16 g = f32x16{};
    const unsigned kml = (unsigned)((r32 & 15) * LD + hi * 8) * 2u;
#pragma unroll
    for (int d0 = 0; d0 < 8; ++d0) { const bf16x8 kf = *(const bf16x8*)((const char*)KM + (kml + d0 * 32));
        g = __builtin_amdgcn_mfma_f32_32x32x16_bf16(kf, qr[d0], g, 0, 0, 0); }
    float gv[16];
#pragma unroll
    for (int r = 0; r < 8; ++r) { auto rr = __builtin_amdgcn_permlane32_swap(__float_as_uint(g[r]), __float_as_uint(g[r]), false, false);
        gv[(r & 3) + 8 * (r >> 2)] = __uint_as_float(rr[0]); gv[(r & 3) + 8 * (r >> 2) + 4] = __uint_as_float(rr[1]); }
    const float NEG = -__builtin_inff();
#pragma unroll
    for (int j = 0; j < 16; ++j) gv[j] = (j < bq) ? gv[j] : NEG;
    unsigned sel = 0u;
#pragma unroll
    for (int it = 0; it < 3; ++it) { float best = NEG; int bi = -1;
#pragma unroll
        for (int j = 0; j < 16; ++j) { const bool gt = gv[j] > best; best = gt ? gv[j] : best; bi = gt ? j : bi; }
        sel |= (bi >= 0) ? (1u << bi) : 0u;
#pragma unroll
        for (int j = 0; j < 16; ++j) gv[j] = (j == bi) ? NEG : gv[j]; }
    return sel;
}
template <int MODE>
__device__ __forceinline__ void block(const Bases& BS, const URef& cur, const URef& nxt, char* lds, Seam& S, const int tid) {
    const int wid = __builtin_amdgcn_readfirstlane(tid >> 6), lane = tid & 63, r32 = lane & 31, hi = lane >> 5;
    constexpr int NT = 4;
    const int qlo = cur.key0 + wid * QBLK, qm = qlo + r32 - 4 * hi;
    char* V_lds = lds; char* K_lds = lds + 2 * SHM_V;
    float* ws = (float*)(lds + WS_OFF) + wid * 256; float* li_l = ws, * al_l = ws + 32; unsigned* entl = (unsigned*)(ws + 64); float* wts = ws + 96;
    char* ost = lds + OST_OFF + wid * 8192;
    float m_reg = -1e30f, l_reg = 0; f32x16 o[4] = {};
    const int sr = tid >> 4, sc = (tid & 15) * 8, vst0 = v_st(sr, sc), vst1 = v_st(32 + sr, sc), kws = KSWZ(sr, sc * 2);
    const unsigned kl0 = (unsigned)(sr * LD + sc) * 2u, kl1 = kl0 + 32u * LD * 2u;
    const int vb0 = (int)(uintptr_t)V_lds + v_rd_base(lane);
    if constexpr (MODE == 1) { if (hi == 0) entl[r32] = S.ent; }
#define RESC(a) do { if (__any((a) < 1.f)) { if (hi == 0) al_l[r32] = (a); asm volatile("s_waitcnt lgkmcnt(0)" ::: "memory");              \
                     for (int d_ = 0; d_ < 4; ++d_) for (int r = 0; r < 16; ++r) o[d_][r] *= al_l[crow(r, hi)]; } } while (0)
#define KBASE(t) (cur.key0 + (t) * KVBLK)
#define MASKT(P0_, P1_, t) do { if constexpr (MODE == 0) { const int kb_ = KBASE(t); if (kb_ + KVBLK - 1 > qlo) mask_causal(P0_, P1_, qm - kb_); } } while (0)
    constexpr int NQL = 8;
#define SEAM_K0() do { VMWN(NQL); SWRITE_HK(0); SBAR(); } while (0)
    f32x16 pA0, pA1, pB0, pB1; float mnA, mnB, alA, alB; bf16x8 pa0, pa1, pa2, pa3;
#if ATT_CLAMP >= 3
    if (true) { l_reg = 1.f; m_reg = 0.f; } else {
#else
    {
#endif
    SWRITE_HV(0); SBAR();
    SLOAD_H(cur.koff, KBASE(1));
    SBAR(); qkt<0>(pA0, pA1, K_lds, r32, hi, S.qr);
    MASKT(pA0, pA1, 0); partialSM(pA0, pA1, m_reg, mnA, alA);
    VMW(); SWRITE_H(1);
    __syncthreads();
#define HALF_STEP(PX0, PX1, mnX, alX, PY0, PY1, alY, t, KB, VB, SB) do {                                                      \
        SBAR(); qkt<KB>(PX0, PX1, K_lds, r32, hi, S.qr);                                             \
        finishSM(PY0, PY1, alY, l_reg, pa0, pa1, pa2, pa3); SBAR();                                                           \
        if ((t) + 1 < NT) { SLOAD_H(cur.koff, KBASE((t) + 1)); SBAR(); }                                               \
        pv_tile<VB>(o, vb0, pa0, pa1, pa2, pa3); MASKT(PX0, PX1, (t)); partialSM(PX0, PX1, m_reg, mnX, alX);                                        \
        __syncthreads();                                                                                                      \
        if ((t) + 1 < NT) { VMW(); SWRITE_H(SB); }                                                                          \
        RESC(alX); __syncthreads(); } while (0)
    HALF_STEP(pB0, pB1, mnB, alB, pA0, pA1, alA, 1, 1, 0, 0);
    HALF_STEP(pA0, pA1, mnA, alA, pB0, pB1, alB, 2, 0, 1, 1);
    { SBAR(); qkt<1>(pB0, pB1, K_lds, r32, hi, S.qr); SBAR(); }
    SLOAD_H(nxt.koff, nxt.key0); SBAR();
    q_loads<MODE>(BS, nxt, S, wid, r32, hi);
    SBAR();
    finishSM(pA0, pA1, alA, l_reg, pa0, pa1, pa2, pa3); SBAR();
    pv_tile<0>(o, vb0, pa0, pa1, pa2, pa3);
    { MASKT(pB0, pB1, NT - 1); partialSM(pB0, pB1, m_reg, mnB, alB); __syncthreads(); RESC(alB);
      finishSM(pB0, pB1, alB, l_reg, pa0, pa1, pa2, pa3); SBAR(); pv_tile<1>(o, vb0, pa0, pa1, pa2, pa3); }
    SBAR(); SEAM_K0();
    }
#if ATT_CLAMP == 4
    __syncthreads(); return;
#endif
    if (hi == 0) li_l[r32] = l_reg; asm volatile("s_waitcnt lgkmcnt(0)" ::: "memory");
    float rli[16];
#pragma unroll
    for (int r = 0; r < 16; ++r) rli[r] = __builtin_amdgcn_rcpf(li_l[crow(r, hi)]);
#pragma unroll
    for (int r = 0; r < 16; ++r) { const int orow = crow(r, hi);
#pragma unroll
        for (int d0 = 0; d0 < 4; ++d0) { const float v = o[d0][r] * rli[r];
            const float vn = __uint_as_float((unsigned)__builtin_amdgcn_update_dpp(0, (int)__float_as_uint(v), 0xB1, 0xF, 0xF, false));
            const unsigned pk = cvt_pk_bf16(v, vn);
            if ((r32 & 1) == 0) *(unsigned*)(ost + (orow * 128 + d0 * 32 + r32) * 2) = pk; } }
    constexpr float C2 = 1.4426950408889634f * SCALE;
    if constexpr (MODE == 1) {
        asm volatile("s_waitcnt lgkmcnt(0)" ::: "memory");
        if ((ATT_SUB >= 2) && hi == 0 && wid * QBLK + r32 < cur.rows) { const unsigned e = entl[r32]; *(f32x2*)(BS.wsb + (BS.oPML + (((cur.pbase + (e & 4095u)) * 3u + (e >> 12) - 1u) << 3))) = (f32x2){m_reg, l_reg}; }
#pragma unroll
        for (int i = 0; i < 8; ++i) { const int row = i * 4 + (lane >> 4), ch = lane & 15; const bf16x8 own = *(const bf16x8*)(ost + (row * 128 + ch * 8) * 2); const unsigned e = entl[row];
            if ((ATT_SUB >= 2) && (ATT_SUB != 4) && wid * QBLK + row < cur.rows) *(bf16x8*)(BS.wsb + (BS.oPART + ((((cur.pbase + (e & 4095u)) * 3u + (e >> 12) - 1u) << 8) + (unsigned)ch * 16u))) = own; }
    } else {
#if ATT_CLAMP == 2
        const int ns = 0;
#else
        const int ns = cur.rows;
#endif
        if (hi == 0) { const unsigned prow = (cur.pbase + (unsigned)(cur.key0 + wid * QBLK + r32)) * 3u; float mk[4], lk[4]; mk[0] = m_reg; lk[0] = l_reg;
#pragma unroll
            for (int s2 = 0; s2 < 3; ++s2) { if (s2 < ns) { const f32x2 t = *(const f32x2*)(BS.wsb + (BS.oPML + ((prow + (unsigned)s2) << 3))); mk[s2 + 1] = t[0]; lk[s2 + 1] = t[1]; } else { mk[s2 + 1] = -1e30f; lk[s2 + 1] = 0.f; } }
            const float M = fmaxf(fmaxf(mk[0], mk[1]), fmaxf(mk[2], mk[3])); float w[4], sum = 0.f;
#pragma unroll
            for (int k = 0; k < 4; ++k) { w[k] = lk[k] * __builtin_amdgcn_exp2f((mk[k] - M) * C2); sum += w[k]; }
            const float inv = __builtin_amdgcn_rcpf(sum);
#pragma unroll
            for (int k = 0; k < 4; ++k) wts[r32 * 4 + k] = w[k] * inv; }
        asm volatile("s_waitcnt lgkmcnt(0)" ::: "memory");
        const unsigned ow_ = BS.oO + cur.qoff + (unsigned)(wid * QBLK) * LD;
#pragma unroll
        for (int i = 0; i < 8; ++i) { const int row = i * 4 + (lane >> 4), ch = lane & 15; const u32x4 own = *(const u32x4*)(ost + (row * 128 + ch * 8) * 2);
            const f32x4 wv = *(const f32x4*)(wts + row * 4);
            float a8[8] = {bf_lo(own.x) * wv[0], bf_hi(own.x) * wv[0], bf_lo(own.y) * wv[0], bf_hi(own.y) * wv[0], bf_lo(own.z) * wv[0], bf_hi(own.z) * wv[0], bf_lo(own.w) * wv[0], bf_hi(own.w) * wv[0]};
            const unsigned pro_ = BS.oPART + (((cur.pbase + (unsigned)(cur.key0 + wid * QBLK + row)) * 3u) << 8) + (unsigned)ch * 16u;
#pragma unroll
            for (int s2 = 0; s2 < 3; ++s2) if (s2 < ns) { const u32x4 p = *(const u32x4*)(BS.wsb + (pro_ + (unsigned)s2 * 256u)); const float wk = wv[s2 + 1];
                a8[0] += bf_lo(p.x) * wk; a8[1] += bf_hi(p.x) * wk; a8[2] += bf_lo(p.y) * wk; a8[3] += bf_hi(p.y) * wk; a8[4] += bf_lo(p.z) * wk; a8[5] += bf_hi(p.z) * wk; a8[6] += bf_lo(p.w) * wk; a8[7] += bf_hi(p.w) * wk; }
            u32x2 w8; w8.x = __builtin_amdgcn_cvt_pk_fp8_f32(a8[2], a8[3], __builtin_amdgcn_cvt_pk_fp8_f32(a8[0], a8[1], 0u, false), true); w8.y = __builtin_amdgcn_cvt_pk_fp8_f32(a8[6], a8[7], __builtin_amdgcn_cvt_pk_fp8_f32(a8[4], a8[5], 0u, false), true);
            *(u32x2*)(BS.wsb + (ow_ + (unsigned)row * LD + (unsigned)ch * 8u)) = w8; }
    }
    __syncthreads();
#undef RESC
#undef KBASE
#undef MASKT
#undef SEAM_K0
#undef HALF_STEP
}
constexpr int R_V = 4 * SHM_K, R_WS = R_V + 4 * SHM_V, R_BYTES = R_WS + NW * 1024;
struct CRef { unsigned qoff; unsigned lbase; int rows; unsigned pbase; int qpos0; int ns; };
struct QState { bf16x8 qr[8]; unsigned ent; };
__device__ __forceinline__ int rb0(int wid) { return wid < 4 ? wid : 11 - wid; }
struct KVRegs { bf16x8 kk[4][2], vv[4][2]; };
__device__ __forceinline__ void load_kv_issue(const Bases& BS, unsigned koff, int key0, const int tid, KVRegs& R) {
    const int sr = tid >> 4, sc = (tid & 15) * 8;
    const unsigned kl0 = (unsigned)(sr * LD + sc) * 2u, kl1 = kl0 + 32u * LD * 2u;
#pragma unroll
    for (int t = 0; t < 4; ++t) { const unsigned ko_ = (koff + (unsigned)(key0 + t * KVBLK) * LD) * 2u;
        R.kk[t][0] = LDG8(BS.oK + ko_ + kl0); R.kk[t][1] = LDG8(BS.oK + ko_ + kl1); R.vv[t][0] = LDG8(BS.oV + ko_ + kl0); R.vv[t][1] = LDG8(BS.oV + ko_ + kl1); }
}
__device__ __forceinline__ void load_kv_commit(char* lds, const int tid, const KVRegs& R) {
    const int sr = tid >> 4, sc = (tid & 15) * 8, vst0 = v_st(sr, sc), vst1 = v_st(32 + sr, sc), kws = KSWZ(sr, sc * 2);
#pragma unroll
    for (int t = 0; t < 4; ++t) { *(bf16x8*)(lds + t * SHM_K + kws) = R.kk[t][0]; *(bf16x8*)(lds + t * SHM_K + kws + KROW32) = R.kk[t][1];
        *(bf16x8*)(lds + R_V + t * SHM_V + vst0) = R.vv[t][0]; *(bf16x8*)(lds + R_V + t * SHM_V + vst1) = R.vv[t][1]; }
}
__device__ __forceinline__ void load_kv(const Bases& BS, unsigned koff, int key0, char* lds, const int tid) { KVRegs R; load_kv_issue(BS, koff, key0, tid, R); load_kv_commit(lds, tid, R); }
template <int MODE> __device__ __forceinline__ void q_loads2(const Bases& BS, const CRef& u, QState& S, int wid, int r32, int hi) {
    unsigned ql;
    if constexpr (MODE == 1) { int row = wid * QBLK + r32; row = row < u.rows ? row : u.rows - 1; S.ent = *(const unsigned short*)(BS.wsb + (BS.oALIST + (u.lbase + (unsigned)row) * 2u)); ql = (unsigned)((S.ent & 4095u) * LD + hi * 8) * 2u; }
    else ql = (unsigned)((wid * QBLK + r32) * LD + hi * 8) * 2u;
    const unsigned qb_ = BS.oQ + u.qoff * 2u + ql;
#pragma unroll
    for (int d0 = 0; d0 < 8; ++d0) S.qr[d0] = LDG8(qb_ + d0 * 32);
}
template <int MODE>
__device__ __forceinline__ void chunk(const Bases& BS, const CRef& cur, const CRef& nxt, const bool has_next, char* lds, QState& S, const int tid, float& mo, float& lo, f32x16 (&o)[4]) {
    const int wid = __builtin_amdgcn_readfirstlane(tid >> 6), lane = tid & 63, r32 = lane & 31, hi = lane >> 5;
    char* K_lds = lds;
    float* ws = (float*)(lds + R_WS) + wid * 256; float* li_l = ws, * al_l = ws + 32; unsigned* entl = (unsigned*)(ws + 64);
    const int vb0 = (int)(uintptr_t)(lds + R_V) + v_rd_base(lane);
    const int wrow = (MODE == 0) ? rb0(wid) : wid;
    const int qlo = cur.qpos0 + wrow * QBLK, qm = qlo + r32 - 4 * hi;
    const bool active = (MODE == 0) || (wid * QBLK < cur.rows);
    float m_reg = -1e30f, l_reg = 0;
#pragma unroll
    for (int d = 0; d < 4; ++d) o[d] = f32x16{};
    if constexpr (MODE == 1) { if (hi == 0) entl[r32] = S.ent; }
    if (active) {
        f32x16 p0, p1; float mn, al; bf16x8 pa0, pa1, pa2, pa3;
#define TILE(t) do { if (MODE == 0 && (t) * KVBLK > wrow * QBLK + QBLK - 1) break; qkt<t>(p0, p1, K_lds, r32, hi, S.qr);                                                                 \
            if constexpr (MODE == 0) { const int kb_ = cur.qpos0 + (t) * KVBLK; if (kb_ + KVBLK - 1 > qlo) mask_causal(p0, p1, qm - kb_); }   \
            if ((t) == 3 && has_next) { SBAR(); q_loads2<MODE>(BS, nxt, S, wid, r32, hi); SBAR(); }                          \
            partialSM(p0, p1, m_reg, mn, al); finishSM(p0, p1, al, l_reg, pa0, pa1, pa2, pa3);                                \
            if (__any(al < 1.f)) { if (hi == 0) al_l[r32] = al; asm volatile("s_waitcnt lgkmcnt(0)" ::: "memory");            \
                for (int d_ = 0; d_ < 4; ++d_) for (int r = 0; r < 16; ++r) o[d_][r] *= al_l[crow(r, hi)]; }                  \
            SBAR(); pv_tile<t>(o, vb0, pa0, pa1, pa2, pa3); } while (0)
        TILE(0); TILE(1); TILE(2); TILE(3);
#undef TILE
    } else if (has_next) { q_loads2<MODE>(BS, nxt, S, wid, r32, hi); }
    mo = m_reg; lo = l_reg;
    if constexpr (MODE == 1) {
        if (active) {
            if (hi == 0) li_l[r32] = l_reg; asm volatile("s_waitcnt lgkmcnt(0)" ::: "memory");
            if (hi == 0 && wid * QBLK + r32 < cur.rows) { const unsigned e = entl[r32]; *(f32x2*)(BS.wsb + (BS.oPML + (((cur.pbase + (e & 4095u)) * 3u + (e >> 12) - 1u) << 3))) = (f32x2){m_reg, l_reg}; }
#pragma unroll
            for (int r = 0; r < 16; ++r) { const int row = crow(r, hi); const float rl = 16.f * __builtin_amdgcn_rcpf(li_l[row]); const unsigned e = entl[row];
                const unsigned pb_ = BS.oPART + ((((cur.pbase + (e & 4095u)) * 3u + (e >> 12) - 1u) << 7) + (unsigned)r32 * 4u);
                const unsigned pk = (unsigned)__builtin_amdgcn_cvt_pk_fp8_f32(o[2][r] * rl, o[3][r] * rl, __builtin_amdgcn_cvt_pk_fp8_f32(o[0][r] * rl, o[1][r] * rl, 0, false), true);
                if (wid * QBLK + row < cur.rows) *(unsigned*)(BS.wsb + pb_) = pk; }
        }
    }
}
__device__ __forceinline__ void own_finish(const Bases& BS, const CRef& cur, char* lds, const int tid, const float m_reg, const float l_reg, const f32x16 (&o)[4],
                                           const CRef& nxt, const unsigned nkoff, const int nkey0, QState& S, KVRegs& R) {
    const int wid = __builtin_amdgcn_readfirstlane(tid >> 6), lane = tid & 63, r32 = lane & 31, hi = lane >> 5;
    float* ws = (float*)(lds + R_WS) + wid * 256; float* li_l = ws; float* wts = ws + 96;
    char* ost = lds + wid * 8192;
    constexpr float C2 = 1.4426950408889634f * SCALE;
    const int ns = cur.ns;
    const int wrow = rb0(wid);
    f32x2 pm[3];
    const unsigned prow = (cur.pbase + (unsigned)(cur.qpos0 + wrow * QBLK + r32)) * 3u;
#pragma unroll
    for (int s2 = 0; s2 < 3; ++s2) pm[s2] = (s2 < ns) ? *(const f32x2*)(BS.wsb + (BS.oPML + ((prow + (unsigned)s2) << 3))) : (f32x2){-1e30f, 0.f};
    unsigned pp[16][3];
#pragma unroll
    for (int r = 0; r < 16; ++r) { const unsigned pro_ = BS.oPART + (((cur.pbase + (unsigned)(cur.qpos0 + wrow * QBLK + crow(r, hi))) * 3u) << 7) + (unsigned)r32 * 4u;
#pragma unroll
        for (int s2 = 0; s2 < 3; ++s2) pp[r][s2] = (s2 < ns) ? *(const unsigned*)(BS.wsb + (pro_ + (unsigned)s2 * 128u)) : 0u; }
    if (hi == 0) li_l[r32] = l_reg;
    if (hi == 0) { const float M = fmaxf(fmaxf(m_reg, pm[0][0]), fmaxf(pm[1][0], pm[2][0]));
        const float w0 = l_reg * __builtin_amdgcn_exp2f((m_reg - M) * C2), w1 = pm[0][1] * __builtin_amdgcn_exp2f((pm[0][0] - M) * C2), w2 = pm[1][1] * __builtin_amdgcn_exp2f((pm[1][0] - M) * C2), w3 = pm[2][1] * __builtin_amdgcn_exp2f((pm[2][0] - M) * C2);
        const float inv = __builtin_amdgcn_rcpf(w0 + w1 + w2 + w3);
        const float inv16 = inv * 0.0625f;
        *(f32x4*)(wts + r32 * 4) = (f32x4){w0 * inv, w1 * inv16, w2 * inv16, w3 * inv16}; }
    asm volatile("s_waitcnt lgkmcnt(0)" ::: "memory");
#pragma unroll
    for (int r = 0; r < 16; ++r) { const int orow = crow(r, hi); const f32x4 wv = *(const f32x4*)(wts + orow * 4); const float w0 = wv[0] * __builtin_amdgcn_rcpf(li_l[orow]);
        float mg[4] = {o[0][r] * w0, o[1][r] * w0, o[2][r] * w0, o[3][r] * w0};
#pragma unroll
        for (int s2 = 0; s2 < 3; ++s2) { const f32x2 p01 = __builtin_amdgcn_cvt_pk_f32_fp8((int)pp[r][s2], false), p23 = __builtin_amdgcn_cvt_pk_f32_fp8((int)pp[r][s2], true); const float wk = wv[s2 + 1];
            mg[0] += p01[0] * wk; mg[1] += p01[1] * wk; mg[2] += p23[0] * wk; mg[3] += p23[1] * wk; }
#pragma unroll
        for (int d0 = 0; d0 < 4; ++d0) { const float v = mg[d0];
            const float vn = __uint_as_float((unsigned)__builtin_amdgcn_update_dpp(0, (int)__float_as_uint(v), 0xB1, 0xF, 0xF, false));
            const unsigned pk = cvt_pk_bf16(v, vn);
            if ((r32 & 1) == 0) *(unsigned*)(ost + (orow * 128 + d0 * 32 + r32) * 2) = pk; } }
    load_kv_issue(BS, nkoff, nkey0, tid, R);
    q_loads2<0>(BS, nxt, S, wrow, r32, hi);
    asm volatile("s_waitcnt lgkmcnt(0)" ::: "memory");
    const unsigned ow_ = BS.oO + cur.qoff + (unsigned)(wrow * QBLK) * LD;
#pragma unroll
    for (int ii = 0; ii < 8; ++ii) { const int row = ii * 4 + (lane >> 4), ch = lane & 15; const u32x4 own = *(const u32x4*)(ost + (row * 128 + ch * 8) * 2);
        u32x2 w8; w8.x = __builtin_amdgcn_cvt_pk_fp8_f32(bf_lo(own.y), bf_hi(own.y), __builtin_amdgcn_cvt_pk_fp8_f32(bf_lo(own.x), bf_hi(own.x), 0u, false), true);
        w8.y = __builtin_amdgcn_cvt_pk_fp8_f32(bf_lo(own.w), bf_hi(own.w), __builtin_amdgcn_cvt_pk_fp8_f32(bf_lo(own.z), bf_hi(own.z), 0u, false), true);
        *(u32x2*)(BS.wsb + (ow_ + (unsigned)row * LD + (unsigned)ch * 8u)) = w8; }
}
#undef LDG8
#undef VMW
#undef VMWN
#undef SLOAD_H
#undef SWRITE_HK
#undef SWRITE_HV
#undef SWRITE_H
#undef SBAR
#undef KSWZ
}

constexpr int NWAVES = 8;
constexpr int N_LAUNCHES = MK_N_LAUNCHES;
constexpr int PER_PHASE = 13;
constexpr size_t MiB = 1u << 20;
constexpr size_t WS_CTL = 0, CTL_ZERO_BYTES = 1 * MiB;
constexpr size_t WS_SGUW = 1 * MiB;
constexpr size_t WS_ROPE = WS_SGUW + 256 * 1024;
constexpr size_t WS_KM = 2 * MiB;
constexpr size_t WS_TOKW = WS_KM + 256 * 1024;
constexpr size_t WS_WR = 3 * MiB;
constexpr size_t WS_LIST = 4 * MiB;
constexpr size_t WS_LISTR = 12 * MiB;
constexpr size_t WS_WIN = 8 * MiB;
constexpr size_t WS_WPA = 44 * MiB, WS_WPB = 48 * MiB, WS_WOUT = 52 * MiB;
constexpr size_t WS_H = 60 * MiB;
constexpr size_t WS_AO = 60 * MiB, WS_GO = 124 * MiB;
constexpr size_t WS_Q = 188 * MiB, WS_K = 252 * MiB, WS_V = 316 * MiB, WS_U = 380 * MiB, WS_VG = 444 * MiB;
constexpr size_t WS_GA = 508 * MiB, WS_GS = 636 * MiB;
constexpr size_t WS_MG = 764 * MiB;
constexpr size_t WS_LOG = 956 * MiB;
constexpr size_t WS_WGU = 976 * MiB;
constexpr size_t WS_WD = 892 * MiB;
constexpr size_t WS_H8 = 380 * MiB;
constexpr size_t WS_HID = 444 * MiB;
constexpr size_t WS_Y = 716 * MiB;
constexpr size_t WS_H1_8 = 892 * MiB;
constexpr size_t WS_WIN8 = 956 * MiB;
constexpr size_t WS_WPA8 = 974 * MiB;
constexpr size_t WS_ALIST = 764 * MiB;
constexpr size_t WS_PML = 772 * MiB;
constexpr size_t WS_PART = 780 * MiB;
constexpr size_t WS_END = 1104 * MiB;
constexpr int CW_TMO = 0, CW_CODE = 1;
constexpr int CW_CNT = 64;
constexpr int CW_WORK = 3072;
constexpr int CW_DONE = 3200;
constexpr int CW_BAR = 4096;
constexpr int CW_ACNT = 49152;
constexpr int CW_SS = 16384;
constexpr int RING_OFF = 0, RING_BYTES = 131072;
constexpr int SCR_BYTES = 8 * 17408;
constexpr int LDSCTL_OFF = 140288, MISC_OFF = LDSCTL_OFF + 320;
static_assert(SCR_BYTES <= LDSCTL_OFF && RING_BYTES + 9 * 256 * 4 <= LDSCTL_OFF, "LDS map");
constexpr int TAB_OFF = LDSCTL_OFF + 1024;
constexpr int TABA_OFF = 145408;
constexpr int LDS_BYTES = 151552;
static_assert(TABA_OFF + 1025 * 4 <= LDS_BYTES && TAB_OFF + (961 + 32) * 4 <= TABA_OFF && att::LDS_BYTES2 <= LDSCTL_OFF && att::R_BYTES <= LDSCTL_OFF, "LDS map");
static_assert(TAB_OFF + 961 * 4 <= LDS_BYTES, "LDS map");

typedef GAS unsigned gu32;
#define RLX_AGENT __ATOMIC_RELAXED, __HIP_MEMORY_SCOPE_AGENT
#define LDS_WAIT() asm volatile("s_waitcnt lgkmcnt(0)" ::: "memory")
#define VM_WAIT() asm volatile("s_waitcnt vmcnt(0)" ::: "memory")

#define XB_TMO      128
#define XB_XCNT(j)  (256  + 64 * (j))
#define XB_XSUB(j)  (1280 + 64 * (j))
#define XB_XGEN(j)  (2304 + 64 * (j))
#define XB_TOP      3328
#define XB_TOPGEN   3392
#define XCD_BAR_WORDS 3456
#define XB_SPIN_CAP (1u << 18)
__device__ __forceinline__ unsigned xb_ld(unsigned* p)              { return __hip_atomic_load(p, __ATOMIC_RELAXED, __HIP_MEMORY_SCOPE_AGENT); }
__device__ __forceinline__ unsigned xb_add(unsigned* p, unsigned v) { return __hip_atomic_fetch_add(p, v, __ATOMIC_RELAXED, __HIP_MEMORY_SCOPE_AGENT); }
__device__ __forceinline__ unsigned xb_xcc_id() { return (unsigned)__builtin_amdgcn_s_getreg((3 << 11) | 20) & 0xFu; }
#define XB_SPIN(cond, bar) do { unsigned _sp = 0; while (cond) { __builtin_amdgcn_s_sleep(1); \
    if ((++_sp & 255u) == 0u) { if (xb_ld(&(bar)[XB_TMO])) break; if (_sp > XB_SPIN_CAP) { atomicAdd(&(bar)[XB_TMO], 1u); break; } } } } while (0)
struct XcdBarrier { unsigned* bar; unsigned x; volatile LAS unsigned* st; };
__device__ __forceinline__ XcdBarrier xcd_barrier_post(unsigned* bar, volatile LAS unsigned* st) {
    XcdBarrier b; b.bar = bar; b.x = xb_xcc_id(); b.st = st;
    if (threadIdx.x == 0) (void)xb_add(&bar[XB_XCNT(b.x)], 1u);
    return b;
}
__device__ __forceinline__ void xcd_barrier_complete(unsigned* bar, unsigned x, unsigned& nloc, unsigned& nx, const unsigned G) {
    unsigned sum, cnt, mine, sp = 0u;
    for (;;) {
        sum = 0u; cnt = 0u; mine = 0u;
#pragma unroll
        for (unsigned j = 0; j < 16; ++j) { const unsigned c = xb_ld(&bar[XB_XCNT(j)]); sum += c; cnt += (c > 0u) ? 1u : 0u; mine = (j == x) ? c : mine; }
        if (sum == G) break;
        __builtin_amdgcn_s_sleep(1);
        if ((++sp & 255u) == 0u) { if (xb_ld(&bar[XB_TMO])) break; if (sp > XB_SPIN_CAP) { atomicAdd(&bar[XB_TMO], 1u); break; } }
    }
    nloc = mine > 0u ? mine : 1u; nx = cnt > 0u ? cnt : 1u;
}
__device__ __forceinline__ void xcd_barrier(const XcdBarrier& b) {
    asm volatile("s_waitcnt vmcnt(0)" ::: "memory");
    __syncthreads();
    if (threadIdx.x == 0) {
        unsigned* bar = b.bar;
        __builtin_amdgcn_s_waitcnt(0);
        unsigned nloc = b.st[0], nx = b.st[1];
        if (nloc == 0u) { xcd_barrier_complete(bar, b.x, nloc, nx, b.st[8]); b.st[0] = nloc; b.st[1] = nx; }
        const unsigned old = xb_add(&bar[XB_XSUB(b.x)], 1u);
        const unsigned gen = old / nloc;
        if (old + 1u == (gen + 1u) * nloc) {
            __builtin_amdgcn_fence(__ATOMIC_RELEASE, "agent");
            asm volatile("s_waitcnt vmcnt(0)" ::: "memory");
            const unsigned og = xb_add(&bar[XB_TOP], 1u);
            const unsigned tg = og / nx;
            if (og + 1u == (tg + 1u) * nx) xb_add(&bar[XB_TOPGEN], 1u);
            else XB_SPIN(xb_ld(&bar[XB_TOPGEN]) == tg, bar);
            __builtin_amdgcn_fence(__ATOMIC_ACQUIRE, "agent");
            xb_add(&bar[XB_XGEN(b.x)], 1u);
            asm volatile("s_waitcnt vmcnt(0)" ::: "memory");
        } else {
            XB_SPIN(xb_ld(&bar[XB_XGEN(b.x)]) == gen, bar);
            __builtin_amdgcn_fence(__ATOMIC_ACQUIRE, "agent");
            asm volatile("s_waitcnt vmcnt(0)" ::: "memory");
        }
    }
    __syncthreads();
}

struct Frame {
    LAS unsigned char* lds;
    volatile LAS unsigned* MISC;
    unsigned* ctl;
    int tid, lane, wave;
    int vcu, G;
    unsigned char* ws;
    float* out;
};

__device__ __forceinline__ float wave_sum(float v) {
#pragma unroll
    for (int o = 1; o < 64; o <<= 1) v += __shfl_xor(v, o);
    return v;
}
__device__ __forceinline__ unsigned f2bf(float f) { unsigned u = __builtin_bit_cast(unsigned, f); return (u + 0x7fffu + ((u >> 16) & 1u)) >> 16; }
__device__ __forceinline__ unsigned pk2(float lo, float hi) { return f2bf(lo) | (f2bf(hi) << 16); }

__device__ __forceinline__ void transpose_item(const float* W, int K, int N, bf16_t* WT, int k0, int n0, int drow0, LAS float* scr, int lane) {
    f32x4 v[8]; const float* src = W + (size_t)(k0 + (lane >> 3)) * N + n0 + 4 * (lane & 7);
#pragma unroll
    for (int i = 0; i < 8; ++i) v[i] = __builtin_nontemporal_load((const f32x4*)(src + (size_t)(8 * i) * N));
#pragma unroll
    for (int i = 0; i < 8; ++i) { LAS float* d = scr + ((lane >> 3) + 8 * i) * 33 + 4 * (lane & 7); d[0] = v[i][0]; d[1] = v[i][1]; d[2] = v[i][2]; d[3] = v[i][3]; }
    LDS_WAIT(); asm volatile("" ::: "memory");
    const int c = lane & 7;
#pragma unroll
    for (int j = 0; j < 4; ++j) { const int n = (lane >> 3) + 8 * j; const LAS float* s = scr + (8 * c) * 33 + n;
        u32x4 o; o.x = pk2(s[0 * 33], s[1 * 33]); o.y = pk2(s[2 * 33], s[3 * 33]); o.z = pk2(s[4 * 33], s[5 * 33]); o.w = pk2(s[6 * 33], s[7 * 33]);
        *(u32x4*)(WT + (size_t)(drow0 + n) * K + k0 + 8 * c) = o; }
    LDS_WAIT(); asm volatile("" ::: "memory");
}
__device__ __forceinline__ unsigned pk4_fp8(float a, float b, float c, float d) { unsigned w = __builtin_amdgcn_cvt_pk_fp8_f32(a, b, 0u, false); return __builtin_amdgcn_cvt_pk_fp8_f32(c, d, w, true); }
__device__ __forceinline__ void t8_issue(const float* W, int N, int k0, int n0, int lane, f32x4 (&v)[16]) {
    const float* src = W + (size_t)(k0 + 16 * (lane >> 3)) * N + n0 + 4 * (lane & 7);
#pragma unroll
    for (int i = 0; i < 16; ++i) v[i] = __builtin_nontemporal_load((const f32x4*)(src + (size_t)i * N));
}
__device__ __forceinline__ void t8_store(const f32x4 (&v)[16], unsigned char* WT, int K, int k0, int drow0, int lane, float scale) {
    unsigned char* dst = WT + (size_t)(drow0 + 4 * (lane & 7)) * K + k0 + 16 * (lane >> 3);
#pragma unroll
    for (int j = 0; j < 4; ++j) { u32x4 o;
        o.x = pk4_fp8(v[0][j] * scale, v[1][j] * scale, v[2][j] * scale, v[3][j] * scale); o.y = pk4_fp8(v[4][j] * scale, v[5][j] * scale, v[6][j] * scale, v[7][j] * scale);
        o.z = pk4_fp8(v[8][j] * scale, v[9][j] * scale, v[10][j] * scale, v[11][j] * scale); o.w = pk4_fp8(v[12][j] * scale, v[13][j] * scale, v[14][j] * scale, v[15][j] * scale);
        *(u32x4*)(dst + (size_t)j * K) = o; }
}
__device__ __forceinline__ void transpose_item8(const float* W, int K, int N, unsigned char* WT, int k0, int n0, int drow0, LAS float* scr, int lane, float scale) {
    (void)scr; f32x4 v[16]; t8_issue(W, N, k0, n0, lane, v); t8_store(v, WT, K, k0, drow0, lane, scale);
}
__device__ __forceinline__ int claim_async(unsigned* ctr, unsigned n) { int ret; asm volatile("global_atomic_add %0, %1, %2, off sc0" : "=v"(ret) : "v"(ctr), "v"(n) : "memory"); return ret; }
struct ConvItem { const float* W; unsigned char* WT; int K, N, k0, n0, drow0; };
__device__ __forceinline__ ConvItem conv_decode(int it, __attribute__((address_space(4))) const char* kp, unsigned char* ws) {
    constexpr int IGU = NE * 2 * (DM / 128) * (FF / 32);
    ConvItem c; int sel; size_t so, dof;
    if (it < IGU) { const int e = it >> 10, r = it & 1023, which = r >> 9, q = r & 511, kb = q >> 5, nb = q & 31, n0 = 32 * nb;
        sel = which; so = (size_t)e * DM * FF; c.K = DM; c.N = FF; dof = WS_WGU + (size_t)e * DM * DM; c.k0 = 128 * kb; c.n0 = n0; c.drow0 = (n0 >> 7) * 256 + which * 128 + (n0 & 127); }
    else { const int j = it - IGU, e = j >> 9, q = j & 511, kb = q >> 6, nb = q & 63;
        sel = 2; so = (size_t)e * FF * DM; c.K = FF; c.N = DM; dof = WS_WD + (size_t)e * DM * FF; c.k0 = 128 * kb; c.n0 = 32 * nb; c.drow0 = 32 * nb; }
    const float* wsrc = (const float*)(GAS const float*)(*(const __attribute__((address_space(4))) unsigned long long*)(kp + 8 * (15 + sel)));
    c.W = wsrc + so; c.WT = ws + dof;
    return c;
}
__device__ __forceinline__ void conv_issue(const ConvItem& c, int lane, f32x4 (&v)[16]) { t8_issue(c.W, c.N, c.k0, c.n0, lane, v); }
__device__ __forceinline__ void conv_process(const ConvItem& cc, const f32x4 (&v)[16], LAS float* scr, int lane, float scale) { (void)scr; t8_store(v, cc.WT, cc.K, cc.k0, cc.drow0, lane, scale); }
__device__ __forceinline__ void transpose_matrix(Frame& F, const float* W, int K, int N, bf16_t* WT, LAS float* scr) {
    const int gw = F.vcu * NWAVES + F.wave, NGW = F.G * NWAVES; const int nblk = N / 32, items = (K / 64) * nblk;
    for (int it = gw; it < items; it += NGW) { const int kb = it / nblk, nb = it % nblk; transpose_item(W, K, N, WT, 64 * kb, 32 * nb, 32 * nb, scr, F.lane); }
}
__device__ __forceinline__ void rms_row_to_bf16(Frame& F, const float* xrow, const float* gain, bf16_t* orow, unsigned* orow8 = nullptr) {
    const f32x4* xr = (const f32x4*)xrow + F.lane; const f32x4* gr = (const f32x4*)gain + F.lane;
    f32x4 v[8]; float s = 0.f;
#pragma unroll
    for (int j = 0; j < 8; ++j) { v[j] = __builtin_nontemporal_load(xr + 64 * j); s += (v[j].x * v[j].x + v[j].y * v[j].y) + (v[j].z * v[j].z + v[j].w * v[j].w); }
    const float rstd = 1.0f / sqrtf(wave_sum(s) * (1.f / DM) + EPS);
    u32x2* o8 = (u32x2*)orow + F.lane;
#pragma unroll
    for (int j = 0; j < 8; ++j) { const f32x4 g = gr[64 * j]; const float y0 = v[j].x * rstd * g.x, y1 = v[j].y * rstd * g.y, y2 = v[j].z * rstd * g.z, y3 = v[j].w * rstd * g.w;
        u32x2 w; w.x = pk2(y0, y1); w.y = pk2(y2, y3); o8[64 * j] = w; if (orow8) orow8[64 * j + F.lane] = pk4_fp8(y0, y1, y2, y3); }
}

struct EpiProj {
    static constexpr bool PERM = true;
    unsigned char* ws; const f32x4* rope; int pn_base;
    __device__ __forceinline__ void operator()(const f32x4 (&acc)[2][2][4][2], const pg8::Unit& u, int wr, int wc, int fr, int fq) const {
#ifdef PROBE_SKIP_EPI
        if (u.x2) return;
#endif
        const int pn = u.pn + pn_base; int mode, ldc, colt; size_t boff;
        if (pn < 20) { const int t = pn >> 2; ldc = 1024; colt = (pn & 3) * 256; boff = WS_Q + (size_t)t * (64 * MiB); mode = (t < 2) ? 1 : (t == 2 ? 0 : 2); }
        else { const int t = (pn - 20) >> 3; ldc = 2048; colt = ((pn - 20) & 7) * 256; boff = WS_GA + (size_t)t * (128 * MiB); mode = 3; }
        bf16_t* base = (bf16_t*)(ws + boff);
        const int row0 = u.pm * 256 + wr * 64 + fr, col0 = colt + wc * 32 + 8 * fq;
        const bool do_rope = (mode == 1) && (wc == 0);
#pragma unroll
        for (int ai = 0; ai < 2; ++ai) {
            f32x4 cs[4][4];
#pragma unroll
            for (int m = 0; m < 4; ++m) { const int row = row0 + ai * 128 + m * 16; const f32x4* rp = rope + (do_rope ? ((size_t)(row & (SEQ - 1)) * 16 + 8 * (fq & 1)) / 2 : (size_t)0);
#pragma unroll
                for (int q = 0; q < 4; ++q) cs[m][q] = rp[q]; }
#pragma unroll
            for (int m = 0; m < 4; ++m) { const int row = row0 + ai * 128 + m * 16; bf16_t* rowp = base + (size_t)row * ldc + col0;
#pragma unroll
                for (int bj = 0; bj < 2; ++bj) { f32x4 v0 = acc[ai][bj][m][0], v1 = acc[ai][bj][m][1];
                    if (do_rope) {
                        float x[8] = {v0[0], v0[1], v0[2], v0[3], v1[0], v1[1], v1[2], v1[3]};
#pragma unroll
                        for (int e = 0; e < 8; ++e) { const auto sw_ = __builtin_amdgcn_permlane32_swap(__float_as_uint(x[e]), __float_as_uint(x[e]), false, false);
                            const float p = __uint_as_float(fq < 2 ? sw_[1] : sw_[0]); const float c = cs[m][e >> 1][(e & 1) * 2], sn = cs[m][e >> 1][(e & 1) * 2 + 1];
                            x[e] = (fq < 2) ? (x[e] * c - p * sn) : (x[e] * c + p * sn); }
                        v0 = (f32x4){x[0], x[1], x[2], x[3]}; v1 = (f32x4){x[4], x[5], x[6], x[7]};
                    } else if (mode == 2) {
#pragma unroll
                        for (int e = 0; e < 4; ++e) { v0[e] = gelu_tanh_f(v0[e]); v1[e] = gelu_tanh_f(v1[e]); }
                    } else if (mode == 3) {
#pragma unroll
                        for (int e = 0; e < 4; ++e) { v0[e] = sigmoid_f(v0[e]); v1[e] = sigmoid_f(v1[e]); }
                    }
                    u32x4 w; w.x = cvt_pk_bf16(v0[0], v0[1]); w.y = cvt_pk_bf16(v0[2], v0[3]); w.z = cvt_pk_bf16(v1[0], v1[1]); w.w = cvt_pk_bf16(v1[2], v1[3]);
                    __builtin_nontemporal_store(w, (u32x4*)(rowp + bj * 128)); } }
#pragma unroll
            for (int m = 0; m < 4; ++m) asm volatile("" :: "v"(cs[m][0]), "v"(cs[m][1]), "v"(cs[m][2]), "v"(cs[m][3]));
        }
    }
};
template <bool ADD> struct EpiGate {
    static constexpr bool PERM = true;
    const bf16_t* gate; bf16_t* out;
    __device__ __forceinline__ void operator()(const f32x4 (&acc)[2][2][4][2], const pg8::Unit& u, int wr, int wc, int fr, int fq) const {
        const int row0 = u.pm * 256 + wr * 64 + fr, col0 = u.pn * 256 + wc * 32 + 8 * fq;
#pragma unroll
        for (int ai = 0; ai < 2; ++ai) {
            u32x4 g[4][2], p[4][2];
#pragma unroll
            for (int m = 0; m < 4; ++m) { const size_t off = (size_t)(row0 + ai * 128 + m * 16) * DM + col0;
#pragma unroll
                for (int bj = 0; bj < 2; ++bj) { g[m][bj] = *(const u32x4*)(gate + off + bj * 128); if (ADD) p[m][bj] = *(const u32x4*)(out + off + bj * 128); } }
#pragma unroll
            for (int m = 0; m < 4; ++m) { const size_t off = (size_t)(row0 + ai * 128 + m * 16) * DM + col0;
#pragma unroll
                for (int bj = 0; bj < 2; ++bj) { const f32x4 v0 = acc[ai][bj][m][0], v1 = acc[ai][bj][m][1]; const u32x4 gg = g[m][bj];
                    float r[8] = {v0[0] * bf_lo(gg.x), v0[1] * bf_hi(gg.x), v0[2] * bf_lo(gg.y), v0[3] * bf_hi(gg.y), v1[0] * bf_lo(gg.z), v1[1] * bf_hi(gg.z), v1[2] * bf_lo(gg.w), v1[3] * bf_hi(gg.w)};
                    if (ADD) { const u32x4 pp = p[m][bj];
                        r[0] += bf_lo(pp.x); r[1] += bf_hi(pp.x); r[2] += bf_lo(pp.y); r[3] += bf_hi(pp.y); r[4] += bf_lo(pp.z); r[5] += bf_hi(pp.z); r[6] += bf_lo(pp.w); r[7] += bf_hi(pp.w); }
                    u32x4 w; w.x = cvt_pk_bf16(r[0], r[1]); w.y = cvt_pk_bf16(r[2], r[3]); w.z = cvt_pk_bf16(r[4], r[5]); w.w = cvt_pk_bf16(r[6], r[7]);
                    *(u32x4*)(out + off + bj * 128) = w; } }
        }
    }
};
struct EpiResNorm {
    static constexpr bool PERM = true;
    const float* x; const float* g; bf16_t* h2u; unsigned char* h2u8; float* ss;
    __device__ __forceinline__ void operator()(const f32x4 (&acc)[2][2][4][2], const pg8::Unit& u, int wr, int wc, int fr, int fq) const {
        const int row0 = u.pm * 256 + wr * 64 + fr, col0 = u.pn * 256 + wc * 32 + 8 * fq;
        f32x4 gv[2][2];
#pragma unroll
        for (int bj = 0; bj < 2; ++bj) { gv[bj][0] = *(const f32x4*)(g + col0 + bj * 128); gv[bj][1] = *(const f32x4*)(g + col0 + bj * 128 + 4); }
#pragma unroll
        for (int ai = 0; ai < 2; ++ai)
#pragma unroll
            for (int mp = 0; mp < 2; ++mp) {
                f32x4 xv[2][2][2];
#pragma unroll
                for (int mm = 0; mm < 2; ++mm) { const size_t off = (size_t)(row0 + ai * 128 + (mp * 2 + mm) * 16) * DM + col0;
#pragma unroll
                    for (int bj = 0; bj < 2; ++bj) { xv[mm][bj][0] = *(const f32x4*)(x + off + bj * 128); xv[mm][bj][1] = *(const f32x4*)(x + off + bj * 128 + 4); } }
#pragma unroll
                for (int mm = 0; mm < 2; ++mm) { const int m = mp * 2 + mm; const int row = row0 + ai * 128 + m * 16; const size_t off = (size_t)row * DM + col0; float sq = 0.f;
#pragma unroll
                    for (int bj = 0; bj < 2; ++bj) { const f32x4 v0 = xv[mm][bj][0] + acc[ai][bj][m][0], v1 = xv[mm][bj][1] + acc[ai][bj][m][1];
                        sq += (v0[0] * v0[0] + v0[1] * v0[1]) + (v0[2] * v0[2] + v0[3] * v0[3]) + (v1[0] * v1[0] + v1[1] * v1[1]) + (v1[2] * v1[2] + v1[3] * v1[3]);
                        const f32x4 h0 = v0 * gv[bj][0], h1 = v1 * gv[bj][1];
                        u32x4 w; w.x = cvt_pk_bf16(h0[0], h0[1]); w.y = cvt_pk_bf16(h0[2], h0[3]); w.z = cvt_pk_bf16(h1[0], h1[1]); w.w = cvt_pk_bf16(h1[2], h1[3]);
                        *(u32x4*)(h2u + off + bj * 128) = w;
                        u32x2 w8; w8.x = pk4_fp8(h0[0], h0[1], h0[2], h0[3]); w8.y = pk4_fp8(h1[0], h1[1], h1[2], h1[3]);
                        *(u32x2*)(h2u8 + off + bj * 128) = w8; }
                    sq += __shfl_xor(sq, 16); sq += __shfl_xor(sq, 32);
                    if (fq == 0 && !u.x2) (void)__hip_atomic_fetch_add(ss + row, sq, __ATOMIC_RELAXED, __HIP_MEMORY_SCOPE_AGENT); }
            }
    }
};
struct EpiLogits {
    static constexpr bool PERM = false;
    float* out;
    __device__ __forceinline__ void operator()(const f32x4 (&acc)[2][2][4][2], const pg8::Unit& u, int wr, int wc, int fr, int fq) const {
        if (wc >= 2) return;
        const int row0 = u.pm * 256 + wr * 64 + fr, col0 = wc * 32 + 4 * fq;
#pragma unroll
        for (int ai = 0; ai < 2; ++ai)
#pragma unroll
            for (int m = 0; m < 4; ++m) { float* rowp = out + (size_t)(row0 + ai * 128 + m * 16) * 64 + col0;
#pragma unroll
                for (int n = 0; n < 2; ++n) *(f32x4*)(rowp + n * 16) = acc[ai][0][m][n]; }
    }
};
struct EpiSwiglu {
    static constexpr bool PERM = true;
    unsigned char* hid; const float* listr;
    __device__ __forceinline__ void operator()(const f32x4 (&acc)[2][2][4][2], const pg8::Unit& u, int wr, int wc, int fr, int fq) const {
        const int row0 = u.pm * 256 + wr * 64 + fr, col0 = u.pn * 128 + wc * 32 + 8 * fq, r0 = wr * 64 + fr;
        float rs[2][4];
#pragma unroll
        for (int ai = 0; ai < 2; ++ai)
#pragma unroll
            for (int m = 0; m < 4; ++m) { const int r = r0 + ai * 128 + m * 16; rs[ai][m] = listr[u.x0 + (r < u.x1 ? r : 0)]; }
#pragma unroll
        for (int ai = 0; ai < 2; ++ai) {
#pragma unroll
            for (int m = 0; m < 4; ++m) { unsigned char* rowp = hid + (size_t)(row0 + ai * 128 + m * 16) * FF + col0;
                const float rstd = rs[ai][m];
                const f32x4 g0 = acc[ai][0][m][0] * rstd, g1 = acc[ai][0][m][1] * rstd, u0 = acc[ai][1][m][0] * rstd, u1 = acc[ai][1][m][1] * rstd;
                float r[8];
#pragma unroll
                for (int e = 0; e < 4; ++e) { r[e] = silu_f(g0[e]) * u0[e]; r[4 + e] = silu_f(g1[e]) * u1[e]; }
                u32x2 w; w.x = pk4_fp8(r[0], r[1], r[2], r[3]); w.y = pk4_fp8(r[4], r[5], r[6], r[7]);
                *(u32x2*)rowp = w; }
        }
    }
};
struct EpiScatter {
    static constexpr bool PERM = true;
    const int* list; unsigned char* Y;
    __device__ __forceinline__ void operator()(const f32x4 (&acc)[2][2][4][2], const pg8::Unit& u, int wr, int wc, int fr, int fq) const {
        const int r0 = wr * 64 + fr, col0 = u.pn * 256 + wc * 32 + 8 * fq;
        int aid[2][4];
#pragma unroll
        for (int ai = 0; ai < 2; ++ai)
#pragma unroll
            for (int m = 0; m < 4; ++m) { const int r = r0 + ai * 128 + m * 16; aid[ai][m] = list[u.x0 + (r < u.x1 ? r : 0)]; }
#pragma unroll
        for (int ai = 0; ai < 2; ++ai)
#pragma unroll
            for (int m = 0; m < 4; ++m) { const int r = r0 + ai * 128 + m * 16;
                if (r < u.x1) { unsigned char* rowp = Y + (size_t)aid[ai][m] * DM + col0;
#pragma unroll
                    for (int bj = 0; bj < 2; ++bj) { const f32x4 v0 = acc[ai][bj][m][0], v1 = acc[ai][bj][m][1];
                        u32x2 w; w.x = pk4_fp8(v0[0], v0[1], v0[2], v0[3]); w.y = pk4_fp8(v1[0], v1[1], v1[2], v1[3]);
                        *(u32x2*)(rowp + bj * 128) = w; } } }
        asm volatile("" :: "v"(aid[0][0]), "v"(aid[0][1]), "v"(aid[0][2]), "v"(aid[0][3]), "v"(aid[1][0]), "v"(aid[1][1]), "v"(aid[1][2]), "v"(aid[1][3]));
    }
};

template <bool GATHER_> struct MoeOrder {
    static constexpr bool GATHER = GATHER_;
    const LAS int* tab; int nrb, G, vcu; const char* A; const char* Bt; size_t a_rb_bytes, b_e_bytes, b_pn_bytes; const int* list;
    __device__ __forceinline__ bool next(int i, pg8::Unit& u) const {
        int Lv = i * G + vcu; const int slots = ((nrb + 3) >> 2) << 5; if (Lv >= slots * REP_MOE) return false; Lv %= slots;
        const int rb = (Lv >> 5) * 4 + ((Lv & 31) >> 3), pn = Lv & 7;
        const int rbc = rb < nrb ? rb : nrb - 1;
        const int e = __builtin_amdgcn_readfirstlane(tab[rbc]); u.pm = rbc; u.pn = pn; u.x0 = __builtin_amdgcn_readfirstlane(tab[320 + rbc]); u.x1 = __builtin_amdgcn_readfirstlane(tab[640 + rbc]); u.x2 = e;
        u.A = GATHER_ ? A : A + (size_t)rbc * a_rb_bytes; u.B = Bt + (size_t)e * b_e_bytes + (size_t)pn * b_pn_bytes; return true;
    }
    const LAS unsigned* rowtab;
    __device__ __forceinline__ unsigned row_off(const pg8::Unit&, int idx, int r) const { return rowtab[idx * 256 + r]; }
};

struct Args { const float* in[19]; float* out; unsigned char* ws; int ph_lo, ph_hi, li, pad; };
static_assert(offsetof(Args, out) == 152 && offsetof(Args, ws) == 160, "kernarg offsets used by KARG_PTR");

__global__ void __launch_bounds__(NWAVES * 64, 2) fwd_kernel(Args args) {
    extern __shared__ __attribute__((aligned(16))) unsigned char lds[];
    { const int t0_ = threadIdx.x; for (int u = t0_; u < (LDS_BYTES - LDSCTL_OFF) / 4; u += NWAVES * 64) ((LAS unsigned*)((LAS unsigned char*)lds + LDSCTL_OFF))[u] = 0u; }
    __syncthreads();
    if (threadIdx.x == 0) ((LAS unsigned*)((LAS unsigned char*)lds + MISC_OFF))[16] = gridDim.x;
    __syncthreads();
    unsigned* const ctl0 = (unsigned*)(args.ws + WS_CTL);
    XcdBarrier bar; bar.bar = ctl0 + CW_BAR; bar.x = 0; bar.st = nullptr;
    if (N_LAUNCHES != PER_PHASE) bar = xcd_barrier_post(ctl0 + CW_BAR + args.li * XCD_BAR_WORDS, (volatile LAS unsigned*)((LAS unsigned char*)lds + MISC_OFF) + 8);
#define GRID_BAR() do { if (N_LAUNCHES == PER_PHASE) { if (threadIdx.x == 0) __hip_atomic_store((unsigned*)(args.ws + WS_CTL) + CW_TMO, 0xBADBA0u, RLX_AGENT); } else { xcd_barrier(bar); } } while (0)
    const int lo = (N_LAUNCHES == 1) ? 0 : args.ph_lo, hi = (N_LAUNCHES == 1) ? PER_PHASE : args.ph_hi;
#ifndef PH_MASK
#define PH_MASK 0xFFFF
#endif
#define IN(k) ((((PH_MASK) >> (k)) & 1) && lo <= (k) && (k) < hi)
#define BOTH(k) (IN(k) && IN((k) + 1))
    typedef __attribute__((address_space(4))) const char* kptr_t;
#define KARG_PTR(T_, off_) ((T_*)(GAS T_*)(*(const __attribute__((address_space(4))) unsigned long long*)(kp_ + (off_))))
#define KARG_IN(k) KARG_PTR(const float, 8 * (k))
#define PH_CTX() \
    int tid_ = threadIdx.x; asm volatile("" : "+v"(tid_)); \
    int bx_ = blockIdx.x, G_ = __builtin_amdgcn_readfirstlane((int)((volatile LAS unsigned*)((LAS unsigned char*)lds + MISC_OFF))[16]); asm volatile("" : "+s"(bx_), "+s"(G_)); \
    kptr_t kp_ = (kptr_t)__builtin_amdgcn_kernarg_segment_ptr(); asm volatile("" : "+s"(kp_)); unsigned char* ws = KARG_PTR(unsigned char, 160); \
    Frame F; F.lds = (LAS unsigned char*)lds; F.MISC = (volatile LAS unsigned*)(F.lds + MISC_OFF); F.tid = tid_; F.lane = tid_ & 63; F.wave = __builtin_amdgcn_readfirstlane(tid_ >> 6); \
    F.G = G_; F.vcu = (G_ % 8 == 0) ? (bx_ % 8) * (G_ / 8) + bx_ / 8 : bx_; F.ws = ws; F.ctl = (unsigned*)(ws + WS_CTL); F.out = KARG_PTR(float, 152); \
    bf16_t* const H = (bf16_t*)(ws + WS_H); const int gw = F.vcu * NWAVES + F.wave, NGW = F.G * NWAVES; (void)H; (void)gw; (void)NGW

#define CONV_LOOP(POLL_, NA_, CH_) do { \
        int tc_ = threadIdx.x; asm volatile("" : "+v"(tc_)); const int lanec_ = tc_ & 63, wavec_ = __builtin_amdgcn_readfirstlane(tc_ >> 6); \
        LAS float* scr_ = nullptr;     \
        kptr_t kp_ = (kptr_t)__builtin_amdgcn_kernarg_segment_ptr(); asm volatile("" : "+s"(kp_)); unsigned char* ws = KARG_PTR(unsigned char, 160);     \
        constexpr int ITOT_ = NE * 2 * (DM / 128) * (FF / 32) + NE * (FF / 128) * (DM / 32);     \
        unsigned* poll_ = (POLL_); \
          \
          \
          \
        volatile LAS int* cl_ = (volatile LAS int*)(F.lds + MISC_OFF + 128); \
        int nb_ = 0, nd_ = 0; \
        if (tc_ == 0) { cl_[0] = (int)__hip_atomic_fetch_add(F.ctl + CW_WORK, 32u, __ATOMIC_RELAXED, __HIP_MEMORY_SCOPE_AGENT); cl_[2] = poll_ ? (int)__hip_atomic_load(poll_, RLX_AGENT) : 0; } \
        __syncthreads(); \
        for (int r_ = 0;; r_ ^= 1) { \
            const int base_ = __builtin_amdgcn_readfirstlane(cl_[r_]), dn_ = __builtin_amdgcn_readfirstlane(cl_[2 + r_]); \
            if (base_ >= ITOT_) break; \
            const bool stop_ = poll_ && dn_ >= (NA_); \
            if (!stop_ && tc_ == 0) { nb_ = claim_async(F.ctl + CW_WORK, 32u); if (poll_) nd_ = (int)__hip_atomic_load(poll_, RLX_AGENT); } \
            _Pragma("unroll 1") for (int hh_ = 0; hh_ < 2; ++hh_) {     \
            const int it_ = base_ + 16 * hh_ + 2 * wavec_; \
            if (it_ < ITOT_) { f32x4 va_[16], vb_[16]; \
              const ConvItem ca_ = conv_decode(it_, kp_, ws); \
              t8_issue(ca_.W, ca_.N, ca_.k0, ca_.n0, lanec_, va_); t8_issue(ca_.W, ca_.N, ca_.k0, ca_.n0 + 32, lanec_, vb_); \
              t8_store(va_, ca_.WT, ca_.K, ca_.k0, ca_.drow0, lanec_, 32.0f); t8_store(vb_, ca_.WT, ca_.K, ca_.k0, ca_.drow0 + 32, lanec_, 32.0f); \
              asm volatile("" : "+v"(nb_) : "v"(va_[15]), "v"(vb_[15])); }     \
            else if (!stop_ && tc_ == 0) asm volatile("s_waitcnt vmcnt(0)" ::: "memory"); } \
            if (stop_) break; \
            if (tc_ == 0) { cl_[r_ ^ 1] = nb_; cl_[2 + (r_ ^ 1)] = nd_; } \
            asm volatile("s_waitcnt lgkmcnt(0)" ::: "memory"); __builtin_amdgcn_s_barrier(); \
        } (void)scr_; } while (0)
#define ROLE_CTX() const bool split_ = (F.G == 320); const bool conv_ = split_ && (F.vcu % 5 == 4); const int na_ = split_ ? 256 : F.G, av_ = split_ ? F.vcu - F.vcu / 5 : F.vcu
#define ROLE_CTX38() const bool split_ = (F.G == 256); const bool conv_ = split_ && ((F.vcu & 7) >= 5); const int na_ = split_ ? 160 : F.G, av_ = split_ ? (F.vcu >> 3) * 5 + (F.vcu & 7) : F.vcu
#define ROLE_DONE(k_) do { __syncthreads(); if (threadIdx.x == 0) (void)__hip_atomic_fetch_add(F.ctl + CW_DONE + 64 * (k_), 1u, __ATOMIC_RELAXED, __HIP_MEMORY_SCOPE_AGENT); } while (0)

    if (IN(0)) {
        PH_CTX();
        for (int rep0_ = 0; rep0_ < REP_P0; ++rep0_) {
        LAS float* scr = (LAS float*)(F.lds + RING_OFF + F.wave * 17408);
        { const int nblk = 1024 / 32, items = (DM / 64) * nblk;
          for (int it = gw; it < items; it += NGW) { const int kb = it / nblk, nb = it % nblk; transpose_item(KARG_IN(2), DM, NPROJ, (bf16_t*)(ws + WS_WIN), 64 * kb, 3072 + 32 * nb, 32 * nb, scr, F.lane); } }
        { LAS float* scr8 = scr;
          constexpr int I1 = (DM / 128) * (NPROJ / 32), I2 = (DA / 128) * (DM / 32);
          for (int it = gw; it < I1 + I2; it += NGW) {
              if (it < I1) { const int kb = it / (NPROJ / 32), nb = it % (NPROJ / 32); transpose_item8(KARG_IN(2), DM, NPROJ, ws + WS_WIN8, 128 * kb, 32 * nb, 32 * nb, scr8, F.lane, 32.0f); }
              else { const int q = it - I1, kb = q / (DM / 32), nb = q % (DM / 32); transpose_item8(KARG_IN(7), DA, DM, ws + WS_WPA8, 128 * kb, 32 * nb, 32 * nb, scr8, F.lane, 32.0f); } } }
        transpose_matrix(F, KARG_IN(8), DS, DM, (bf16_t*)(ws + WS_WPB), scr);
        transpose_matrix(F, KARG_IN(9), DM, DM, (bf16_t*)(ws + WS_WOUT), scr);
        const int gt = F.vcu * (NWAVES * 64) + F.tid, NGT = F.G * NWAVES * 64;
        { bf16_t* WR = (bf16_t*)(ws + WS_WR); const float* wrg = KARG_IN(11); const float* wre = KARG_IN(13);
          for (int i = gt; i < 256 * DM; i += NGT) { const int j = i / DM, k = i % DM; float v = 0.f; if (j < 4) v = wrg[k * 4 + j]; else if (j < 36) v = wre[k * 32 + (j - 4)]; WR[i] = (bf16_t)f2bf(v); } }
        { bf16_t* SW = (bf16_t*)(ws + WS_SGUW); const float* sw = KARG_IN(3);
          for (int i = gt; i < SGU_G * 128 * 128; i += NGT) { const int t = (i >> 7) & 127, s = i & 127; SW[i] = (bf16_t)f2bf(s <= t ? sw[i] : 0.f); } }
        { float* RT = (float*)(ws + WS_ROPE);
          for (int i = gt; i < SEQ * 16; i += NGT) { const int pos = i >> 4, j = i & 15; const float inv = powf(500000.0f, -(float)j / 16.0f); const float ang = (float)pos * inv; RT[2 * i] = cosf(ang); RT[2 * i + 1] = sinf(ang); } }
        for (int m = gw; m < T; m += NGW) rms_row_to_bf16(F, KARG_IN(0) + (size_t)m * DM, KARG_IN(1), H + (size_t)m * DM, (unsigned*)(ws + WS_H1_8 + (size_t)m * DM));
        }
        if (BOTH(0)) GRID_BAR();
    }
    if (IN(1)) {
        PH_CTX();
        {
            pg8::DenseOrder S; S.init(ws + WS_H1_8, ws + WS_WIN8, T, 256 * 32, DM / 2, F.G, bx_, ((REP_GEMM >> 1) & 1) + 1, 12, 4);
            EpiProj E{ws, (const f32x4*)(ws + WS_ROPE), 0};
            pg8::gemm_phase<EpiProj, pg8::DenseOrder, true, true, true>(F.lds + RING_OFF, DM / 2, S, E, F.tid);
        }
        {
            pg8::DenseOrder S; S.init(H, ws + WS_WIN, T, 256 * 4, DM, F.G, bx_, ((REP_GEMM >> 1) & 1) + 1);
            EpiProj E{ws, (const f32x4*)(ws + WS_ROPE), 12};
            pg8::gemm_phase<EpiProj, pg8::DenseOrder, true, true>(F.lds + RING_OFF, DM, S, E, F.tid);
        }
        if (BOTH(1)) GRID_BAR();
    }
    if (IN(2)) {
        PH_CTX();
        const bf16_t* Kb = (const bf16_t*)(ws + WS_K); bf16_t* KM = (bf16_t*)(ws + WS_KM);
        LAS float* red = (LAS float*)(F.lds + RING_OFF);
        for (int it = F.vcu; it < BATCH * NBLK * NH; it += F.G) {
            const int h = it & 7, bb = it >> 3;
            const int cc = F.tid & 15, rg = F.tid >> 4;
            float s[8] = {0.f, 0.f, 0.f, 0.f, 0.f, 0.f, 0.f, 0.f};
            const bf16_t* src = Kb + ((size_t)bb * 256 + rg) * 1024 + h * 128 + cc * 8;
#pragma unroll
            for (int j = 0; j < 8; ++j) { const u32x4 v = *(const u32x4*)(src + (size_t)j * 32 * 1024);
                s[0] += bf_lo(v.x); s[1] += bf_hi(v.x); s[2] += bf_lo(v.y); s[3] += bf_hi(v.y); s[4] += bf_lo(v.z); s[5] += bf_hi(v.z); s[6] += bf_lo(v.w); s[7] += bf_hi(v.w); }
#pragma unroll
            for (int e = 0; e < 8; ++e) red[rg * 128 + cc * 8 + e] = s[e];
            __syncthreads();
            if (F.tid < 128) { float a = 0.f;
#pragma unroll 8
                for (int r = 0; r < 32; ++r) a += red[r * 128 + F.tid];
                KM[(size_t)bb * 1024 + h * 128 + F.tid] = (bf16_t)f2bf(a * (1.0f / 256.0f)); }
            __syncthreads();
        }
        if (BOTH(2)) GRID_BAR();
    }
    if (IN(3)) {
        PH_CTX();
        att::Bases BS; BS.wsb = ws; BS.oQ = (unsigned)WS_Q; BS.oK = (unsigned)WS_K; BS.oV = (unsigned)WS_V; BS.oO = (unsigned)WS_AO; BS.oPART = (unsigned)WS_PART; BS.oPML = (unsigned)WS_PML; BS.oALIST = (unsigned)WS_ALIST;
        unsigned* ACNT = F.ctl + CW_ACNT;
        {
            LAS unsigned* lcnt = (LAS unsigned*)(F.lds + RING_OFF);
            const bf16_t* KM = (const bf16_t*)(ws + WS_KM); unsigned short* AL = (unsigned short*)(ws + WS_ALIST);
            int tS = threadIdx.x; asm volatile("" : "+v"(tS)); const int laneS = tS & 63, r32 = laneS & 31, hi = laneS >> 5, waveS = __builtin_amdgcn_readfirstlane(tS >> 6);
            for (int it = F.vcu; it < BATCH * NH * 15; it += F.G) {
                const int bh = it / 15, bq = it % 15 + 1, b = bh >> 3, h = bh & 7;
                if (tS < 32) lcnt[tS] = 0u;
                __syncthreads();
                const bf16_t* qb = (const bf16_t*)(ws + WS_Q) + ((size_t)(b * SEQ + bq * 256) * 1024 + h * 128); const unsigned ql = (unsigned)((waveS * 32 + r32) * 1024 + hi * 8) * 2u;
                bf16x8 qr[8];
#pragma unroll
                for (int d0 = 0; d0 < 8; ++d0) qr[d0] = *(const bf16x8*)((const char*)qb + (ql + d0 * 32));
                unsigned m = att::moba_select(qr, KM + ((size_t)b * NBLK * 1024 + h * 128), bq, r32, hi);
                int j0 = -1, j1 = -1, j2 = -1; unsigned k0 = 0, k1 = 0, k2 = 0;
                if (hi == 0) {
                    if (m) { j0 = __builtin_ctz(m); m &= m - 1; k0 = __hip_atomic_fetch_add(lcnt + j0, 1u, __ATOMIC_RELAXED, __HIP_MEMORY_SCOPE_WORKGROUP); }
                    if (m) { j1 = __builtin_ctz(m); m &= m - 1; k1 = __hip_atomic_fetch_add(lcnt + j1, 1u, __ATOMIC_RELAXED, __HIP_MEMORY_SCOPE_WORKGROUP); }
                    if (m) { j2 = __builtin_ctz(m); k2 = __hip_atomic_fetch_add(lcnt + j2, 1u, __ATOMIC_RELAXED, __HIP_MEMORY_SCOPE_WORKGROUP); }
                }
                __syncthreads();
                if (tS < 16) { const unsigned cn = lcnt[tS]; lcnt[16 + tS] = cn ? atomicAdd(ACNT + bh * 16 + tS, cn) : 0u; }
                __syncthreads();
                if (hi == 0) { const unsigned qpos = (unsigned)(bq * 256 + waveS * 32 + r32);
                    if (j0 >= 0) AL[(size_t)(bh * 16 + j0) * att::LCAP + lcnt[16 + j0] + k0] = (unsigned short)(qpos | (1u << 12));
                    if (j1 >= 0) AL[(size_t)(bh * 16 + j1) * att::LCAP + lcnt[16 + j1] + k1] = (unsigned short)(qpos | (2u << 12));
                    if (j2 >= 0) AL[(size_t)(bh * 16 + j2) * att::LCAP + lcnt[16 + j2] + k2] = (unsigned short)(qpos | (3u << 12)); }
                __syncthreads();
            }
        }
        GRID_BAR();
        {
            ROLE_CTX38();
            if (conv_) { CONV_LOOP(F.ctl + CW_DONE, na_, 2); } else {
            LAS int* pre = (LAS int*)(F.lds + TABA_OFF);
            int tA = threadIdx.x; asm volatile("" : "+v"(tA)); const int laneA = tA & 63;
            if (tA < 64) { int c[16]; int sum = 0;
#pragma unroll
                for (int k = 0; k < 16; ++k) { const int cn = (int)__hip_atomic_load(ACNT + laneA * 16 + k, RLX_AGENT); c[k] = (cn + 255) >> 8; sum += c[k]; }
                int inc = sum;
#pragma unroll
                for (int o = 1; o < 64; o <<= 1) { const int t = __shfl_up(inc, o); if (laneA >= o) inc += t; }
                int ex = inc - sum;
#pragma unroll
                for (int k = 0; k < 16; ++k) { pre[laneA * 16 + k] = ex; ex += c[k]; }
                if (laneA == 63) pre[1024] = inc; }
            __syncthreads();
            int NU = __builtin_amdgcn_readfirstlane(pre[1024]); NU = NU < 0 ? 0 : (NU > 7680 ? 7680 : NU);
            const int ub = (int)(((long)av_ * NU * REP_A2) / na_), ue = (int)(((long)(av_ + 1) * NU * REP_A2) / na_);
            if (ub < ue) {
                int li, cc, cnt, nch;
                { int lo_ = 0, hi_ = 1024; const int u0 = ub % NU;
#pragma unroll
                  for (int s_ = 0; s_ < 10; ++s_) { const int mid_ = (lo_ + hi_) >> 1; if (pre[mid_] <= u0) lo_ = mid_; else hi_ = mid_; }
                  li = __builtin_amdgcn_readfirstlane(lo_); cc = u0 - __builtin_amdgcn_readfirstlane(pre[li]); cnt = (int)__builtin_amdgcn_readfirstlane(__hip_atomic_load(ACNT + li, RLX_AGENT)); nch = (cnt + 255) >> 8; }
#define MKC1(r) do { const int bh_ = li >> 4, b_ = bh_ >> 3, h_ = bh_ & 7; (r).qoff = (unsigned)(b_ * SEQ * 1024 + h_ * 128); (r).lbase = (unsigned)(li * att::LCAP + cc * 256); \
                    (r).rows = (cnt - cc * 256) < 256 ? ((cnt - cc * 256) < 1 ? 1 : (cnt - cc * 256)) : 256; (r).pbase = (unsigned)(bh_ * 4096); (r).qpos0 = 0; (r).ns = 0; } while (0)
#define ADV1() do { ++cc; if (cc >= nch) { cc = 0; do { li = (li + 1) & 1023; cnt = (int)__builtin_amdgcn_readfirstlane(__hip_atomic_load(ACNT + li, RLX_AGENT)); nch = (cnt + 255) >> 8; } while (nch == 0); } } while (0)
                att::QState S; att::CRef cur; MKC1(cur);
                { const int wid_ = __builtin_amdgcn_readfirstlane(tA >> 6); att::q_loads2<1>(BS, cur, S, wid_, laneA & 31, laneA >> 5); }
                int resident = -1;
                for (int u = ub; u < ue; ++u) {
                    if (li != resident) { __syncthreads(); att::load_kv(BS, cur.qoff, (li & 15) * 256, (char*)lds + RING_OFF, tA); __syncthreads(); resident = li; }
                    const bool has_next = (u + 1 < ue);
                    att::CRef nxt = cur; if (has_next) { ADV1(); MKC1(nxt); }
                    float mo, lo2; f32x16 oacc[4];
                    att::chunk<1>(BS, cur, nxt, has_next, (char*)lds + RING_OFF, S, tA, mo, lo2, oacc);
                    cur = nxt;
                }
                __syncthreads();
#undef MKC1
#undef ADV1
            }
            ROLE_DONE(0);
            }
        }
        GRID_BAR();
        {
            const int NU = BATCH * NH * 16 * REP_ATT;
            int tB = threadIdx.x; asm volatile("" : "+v"(tB)); const int laneB = tB & 63, widB = __builtin_amdgcn_readfirstlane(tB >> 6);
#define MKC0(r, ko, k0, u_) do { const int uu = (u_) % (BATCH * NH * 16), bh_ = uu >> 4, bq_ = uu & 15, b_ = bh_ >> 3, h_ = bh_ & 7; (ko) = (unsigned)(b_ * SEQ * 1024 + h_ * 128); (k0) = bq_ * 256; \
                (r).qoff = (ko) + (unsigned)(bq_ * 256 * 1024); (r).lbase = 0u; (r).rows = 256; (r).pbase = (unsigned)(bh_ * 4096); (r).qpos0 = bq_ * 256; (r).ns = bq_ < 3 ? bq_ : 3; } while (0)
            ROLE_CTX();
            if (conv_) { CONV_LOOP(F.ctl + CW_DONE + 64, na_, 2); } else {
            if (av_ < NU) {
                att::CRef cur; unsigned koff; int key0; MKC0(cur, koff, key0, av_);
                att::QState S; att::KVRegs R;
                att::q_loads2<0>(BS, cur, S, att::rb0(widB), laneB & 31, laneB >> 5);
                att::load_kv_issue(BS, koff, key0, tB, R);
                for (int u = av_; u < NU; u += na_) {
                    __syncthreads();
                    att::load_kv_commit((char*)lds + RING_OFF, tB, R);
                    __syncthreads();
                    float mo, lo2; f32x16 oacc[4];
                    att::chunk<0>(BS, cur, cur, false, (char*)lds + RING_OFF, S, tB, mo, lo2, oacc);
                    __syncthreads();
                    att::CRef nxt = cur; unsigned nkoff = koff; int nkey0 = key0;
                    if (u + na_ < NU) MKC0(nxt, nkoff, nkey0, u + na_);
                    att::own_finish(BS, cur, (char*)lds + RING_OFF, tB, mo, lo2, oacc, nxt, nkoff, nkey0, S, R);
                    cur = nxt; koff = nkoff; key0 = nkey0;
                }
            }
#undef MKC0
            ROLE_DONE(1);
            }
            __syncthreads();
        }
        __syncthreads();
        {
            const bf16_t* Ub = (const bf16_t*)(ws + WS_U); const bf16_t* VGb = (const bf16_t*)(ws + WS_VG); bf16_t* Gb = (bf16_t*)(ws + WS_GO);
            const bf16_t* SW = (const bf16_t*)(ws + WS_SGUW); const float* sgu_b = KARG_IN(4); const float* ln_g = KARG_IN(5); const float* ln_b = KARG_IN(6);
            constexpr int VTP = 136;
            LAS bf16_t* vT = (LAS bf16_t*)(F.lds + RING_OFF);
            LAS float* stat = (LAS float*)(F.lds + RING_OFF + 128 * VTP * 2);
            int tG = threadIdx.x; asm volatile("" : "+v"(tG)); const int laneG = tG & 63, waveG = __builtin_amdgcn_readfirstlane(tG >> 6), r32 = laneG & 31, hi = laneG >> 5;
            for (int n0 = F.vcu; n0 < (T / SGU_CHUNK) * REP_SGU; n0 += F.G) { const int n = n0 % (T / SGU_CHUNK);
                const size_t t0 = (size_t)n * SGU_CHUNK;
                { u32x4 sa[16], sb[16];
#pragma unroll
                for (int rr = 0; rr < 16; ++rr) { const u32x4* p = (const u32x4*)(VGb + (t0 + waveG * 16 + rr) * 1024) + laneG * 2; sa[rr] = p[0]; sb[rr] = p[1]; }
#pragma unroll
                for (int rr = 0; rr < 16; ++rr) { const int row = waveG * 16 + rr;
                    const u32x4 a = sa[rr], b = sb[rr]; float v[16] = {bf_lo(a.x), bf_hi(a.x), bf_lo(a.y), bf_hi(a.y), bf_lo(a.z), bf_hi(a.z), bf_lo(a.w), bf_hi(a.w), bf_lo(b.x), bf_hi(b.x), bf_lo(b.y), bf_hi(b.y), bf_lo(b.z), bf_hi(b.z), bf_lo(b.w), bf_hi(b.w)};
                    float s = 0.f;
#pragma unroll
                    for (int e = 0; e < 16; ++e) s += v[e];
                    const float mean = wave_sum(s) * (1.f / 1024.f); float q = 0.f;
#pragma unroll
                    for (int e = 0; e < 16; ++e) { const float d = v[e] - mean; q += d * d; }
                    const float rstd = 1.0f / sqrtf(wave_sum(q) * (1.f / 1024.f) + EPS);
                    if (laneG == 0) { stat[row * 2] = mean; stat[row * 2 + 1] = rstd; } } }
                __syncthreads();
                for (int g = 0; g < SGU_G; ++g) {
                    const int tt = waveG >> 1, ct0 = (waveG & 1) * 2;
                    u32x4 vv[4];
#pragma unroll
                    for (int i = 0; i < 4; ++i) { const int q = tG + 512 * i, s_ = q >> 4, cc = (q & 15) * 8; vv[i] = *(const u32x4*)(VGb + (t0 + s_) * 1024 + g * 128 + cc); }
                    const bf16_t* wrow = SW + ((size_t)g * 128 + tt * 32 + r32) * 128 + hi * 8;
                    bf16x8 af[8];
#pragma unroll
                    for (int ks = 0; ks < 8; ++ks) af[ks] = *(const bf16x8*)(wrow + ks * 16);
                    const size_t orow_ = (t0 + tt * 32 + r32) * 1024 + g * 128 + ct0 * 32 + hi * 4;
                    u32x2 uu0[4], uu1[4];
#pragma unroll
                    for (int q = 0; q < 4; ++q) { uu0[q] = *(const u32x2*)(Ub + orow_ + q * 8); uu1[q] = *(const u32x2*)(Ub + orow_ + 32 + q * 8); }
                    const float bias = sgu_b[g * 128 + tt * 32 + r32];
#pragma unroll
                    for (int i = 0; i < 4; ++i) { const int q = tG + 512 * i, s = q >> 4, cc = (q & 15) * 8;
                        const u32x4 v = vv[i];
                        const float mean = stat[s * 2], rstd = stat[s * 2 + 1];
                        const f32x4 g0 = *(const f32x4*)(ln_g + g * 128 + cc), g1 = *(const f32x4*)(ln_g + g * 128 + cc + 4), b0 = *(const f32x4*)(ln_b + g * 128 + cc), b1 = *(const f32x4*)(ln_b + g * 128 + cc + 4);
                        float y[8] = {bf_lo(v.x), bf_hi(v.x), bf_lo(v.y), bf_hi(v.y), bf_lo(v.z), bf_hi(v.z), bf_lo(v.w), bf_hi(v.w)};
#pragma unroll
                        for (int e = 0; e < 8; ++e) { const float gg = e < 4 ? g0[e & 3] : g1[e & 3], bb = e < 4 ? b0[e & 3] : b1[e & 3]; y[e] = (y[e] - mean) * rstd * gg + bb; vT[(cc + e) * VTP + s] = (bf16_t)f2bf(y[e]); } }
                    __syncthreads();
                    f32x16 acc0 = f32x16{}, acc1 = f32x16{};
#pragma unroll
                    for (int ks = 0; ks < 8; ++ks) if (ks < 2 * (tt + 1)) {
                        const bf16x8 b0 = *(const LAS bf16x8*)(vT + (ct0 * 32 + r32) * VTP + ks * 16 + hi * 8);
                        const bf16x8 b1 = *(const LAS bf16x8*)(vT + ((ct0 + 1) * 32 + r32) * VTP + ks * 16 + hi * 8);
                        acc0 = __builtin_amdgcn_mfma_f32_32x32x16_bf16(b0, af[ks], acc0, 0, 0, 0);
                        acc1 = __builtin_amdgcn_mfma_f32_32x32x16_bf16(b1, af[ks], acc1, 0, 0, 0);
                    }
#pragma unroll
                    for (int q = 0; q < 4; ++q) {
                        u32x2 w0, w1;
                        w0.x = cvt_pk_bf16(bf_lo(uu0[q].x) * (acc0[4 * q + 0] + bias), bf_hi(uu0[q].x) * (acc0[4 * q + 1] + bias)); w0.y = cvt_pk_bf16(bf_lo(uu0[q].y) * (acc0[4 * q + 2] + bias), bf_hi(uu0[q].y) * (acc0[4 * q + 3] + bias));
                        w1.x = cvt_pk_bf16(bf_lo(uu1[q].x) * (acc1[4 * q + 0] + bias), bf_hi(uu1[q].x) * (acc1[4 * q + 1] + bias)); w1.y = cvt_pk_bf16(bf_lo(uu1[q].y) * (acc1[4 * q + 2] + bias), bf_hi(uu1[q].y) * (acc1[4 * q + 3] + bias));
                        *(u32x2*)(Gb + orow_ + q * 8) = w0; *(u32x2*)(Gb + orow_ + 32 + q * 8) = w1; }
                    __syncthreads();
                }
            }
        }
        if (BOTH(3)) GRID_BAR();
    }
    if (IN(4)) {
        PH_CTX();
        pg8::DenseOrder S; S.init(ws + WS_AO, ws + WS_WPA8, T, DM, DA / 2, F.G, bx_, ((REP_GEMM >> 4) & 1) + 1);
        EpiGate<false> E{(const bf16_t*)(ws + WS_GA), (bf16_t*)(ws + WS_MG)};
        pg8::gemm_phase<EpiGate<false>, pg8::DenseOrder, true, true, true>(F.lds + RING_OFF, DA / 2, S, E, F.tid);
    }
    if (IN(5)) {
        PH_CTX();
        pg8::DenseOrder S; S.init(ws + WS_GO, ws + WS_WPB, T, DM, DS, F.G, bx_);
        EpiGate<true> E{(const bf16_t*)(ws + WS_GS), (bf16_t*)(ws + WS_MG)};
        pg8::gemm_phase<EpiGate<true>, pg8::DenseOrder, true, true>(F.lds + RING_OFF, DS, S, E, F.tid);
        if (BOTH(5)) GRID_BAR();
    }
    if (IN(6)) {
        PH_CTX();
        pg8::DenseOrder S; S.init(ws + WS_MG, ws + WS_WOUT, T, DM, DM, F.G, bx_, ((REP_GEMM >> 6) & 1) + 1);
        EpiResNorm E{KARG_IN(0), KARG_IN(10), H, ws + WS_H8, (float*)(F.ctl + CW_SS)};
        pg8::gemm_phase<EpiResNorm, pg8::DenseOrder, true, true>(F.lds + RING_OFF, DM, S, E, F.tid);
        if (BOTH(6)) GRID_BAR();
    }
    if (IN(7)) {
        PH_CTX();
        { pg8::DenseOrder S; S.init(H, ws + WS_WR, T, 256, DM, F.G, bx_);
          EpiLogits E{(float*)(ws + WS_LOG)};
          pg8::gemm_phase<EpiLogits, pg8::DenseOrder, false, true>(F.lds + RING_OFF, DM, S, E, F.tid); }
        __syncthreads();
        CONV_LOOP((unsigned*)nullptr, 0, 4);
        if (BOTH(7)) GRID_BAR();
    }
    if (IN(8)) { if (BOTH(8)) {   } }
    if (IN(9)) {
        PH_CTX();
        const float* LG = (const float*)(ws + WS_LOG); const float* brg = KARG_IN(12); const float* bre = KARG_IN(14);
        float* TW = (float*)(ws + WS_TOKW); int* LIST = (int*)(ws + WS_LIST); unsigned* CNT = F.ctl + CW_CNT; const float* SSQ = (const float*)(F.ctl + CW_SS);
        LAS unsigned* lcnt = (LAS unsigned*)(F.lds + RING_OFF);
        for (int base_t = F.vcu * 128; base_t < T; base_t += F.G * 128) {
            if (F.tid < 64) lcnt[F.tid] = 0u;
            __syncthreads();
            const int t = base_t + F.tid; const bool act = F.tid < 128 && t < T;
            int e0 = 0, e1 = 0; unsigned r0 = 0, r1 = 0; float w0 = 0.f, w1 = 0.f, rstd_t = 0.f;
            if (act) {
            const float* lr = LG + (size_t)t * 64; const float rstd = 1.0f / sqrtf(SSQ[t] * (1.f / DM) + EPS); rstd_t = rstd;
            float gl[4];
#pragma unroll
            for (int j = 0; j < 4; ++j) gl[j] = lr[j] * rstd + brg[j];
            float gmax = gl[0]; int grp = 0;
#pragma unroll
            for (int j = 1; j < 4; ++j) { const bool gt = gl[j] > gmax; gmax = gt ? gl[j] : gmax; grp = gt ? j : grp; }
            float gs = 0.f;
#pragma unroll
            for (int j = 0; j < 4; ++j) gs += __expf(gl[j] - gmax);
            const float p_grp = 1.0f / gs;
            float el[8];
#pragma unroll
            for (int j = 0; j < 8; ++j) el[j] = lr[4 + grp * 8 + j] * rstd + bre[grp * 8 + j];
            float b0 = el[0]; int i0 = 0;
#pragma unroll
            for (int j = 1; j < 8; ++j) { const bool gt = el[j] > b0; b0 = gt ? el[j] : b0; i0 = gt ? j : i0; }
            float b1 = -__builtin_inff(); int i1 = 0;
#pragma unroll
            for (int j = 0; j < 8; ++j) { const bool gt = (j != i0) && (el[j] > b1); b1 = gt ? el[j] : b1; i1 = gt ? j : i1; }
            const float d = __expf(b1 - b0);
            w0 = p_grp / (1.0f + d); w1 = p_grp * d / (1.0f + d);
            e0 = grp * 8 + i0; e1 = grp * 8 + i1;
            r0 = __hip_atomic_fetch_add(lcnt + e0, 1u, __ATOMIC_RELAXED, __HIP_MEMORY_SCOPE_WORKGROUP); r1 = __hip_atomic_fetch_add(lcnt + e1, 1u, __ATOMIC_RELAXED, __HIP_MEMORY_SCOPE_WORKGROUP);
            }
            __syncthreads();
            if (F.tid < 32) { const unsigned cn = lcnt[F.tid]; lcnt[32 + F.tid] = cn ? atomicAdd(CNT + 64 * F.tid, cn) : 0u; }
            __syncthreads();
            if (act) { const unsigned p0 = lcnt[32 + e0] + r0, p1 = lcnt[32 + e1] + r1;
                LIST[(size_t)e0 * T + p0] = 2 * t; LIST[(size_t)e1 * T + p1] = 2 * t + 1; TW[2 * t] = w0; TW[2 * t + 1] = w1;
                float* LISTR = (float*)(ws + WS_LISTR); LISTR[(size_t)e0 * T + p0] = rstd_t; LISTR[(size_t)e1 * T + p1] = rstd_t; }
            __syncthreads();
        }
        if (BOTH(9)) GRID_BAR();
    }
    if (IN(10) || IN(11)) {
        PH_CTX();
        LAS int* tab = (LAS int*)(F.lds + TAB_OFF);
        if (F.tid < NE) tab[961 + F.tid] = (int)__hip_atomic_load(F.ctl + CW_CNT + 64 * F.tid, RLX_AGENT);
        __syncthreads();
        if (F.tid == 0) { int nrb = 0;
            for (int e = 0; e < NE; ++e) { const int c = tab[961 + e];
                for (int p = 0; p < c; p += 256) { tab[nrb] = e; tab[320 + nrb] = e * T + p; tab[640 + nrb] = (c - p) < 256 ? (c - p) : 256; ++nrb; } }
            tab[960] = nrb; }
        __syncthreads();
        const int nrb = __builtin_amdgcn_readfirstlane(tab[960]);
        if (IN(10)) {
            MoeOrder<true> S; S.tab = tab; S.nrb = nrb; S.G = F.G; S.vcu = F.vcu; S.A = (const char*)(ws + WS_H8); S.Bt = (const char*)(ws + WS_WGU); S.a_rb_bytes = 0; S.b_e_bytes = (size_t)DM * DM; S.b_pn_bytes = (size_t)256 * DM; S.list = (const int*)(ws + WS_LIST);
            { LAS unsigned* rt = (LAS unsigned*)(F.lds + RING_BYTES);
              S.rowtab = rt;
#pragma unroll 1
              for (int i = 0; i < 9; ++i) { pg8::Unit u; const bool ok = S.next(i, u); if (!ok) break;
                  if (F.tid < 256) { const int r = F.tid; const int a = S.list[u.x0 + (r < u.x1 ? r : 0)]; rt[i * 256 + r] = (unsigned)(a >> 1) * (unsigned)DM; } }
              __syncthreads(); }
            EpiSwiglu E{ws + WS_HID, (const float*)(ws + WS_LISTR)};
            pg8::gemm_phase<EpiSwiglu, MoeOrder<true>, true, true, true>(F.lds + RING_OFF, DM / 2, S, E, F.tid);
            if (BOTH(10)) GRID_BAR();
        }
        if (IN(11)) {
            MoeOrder<false> S; S.tab = tab; S.nrb = nrb; S.G = F.G; S.vcu = F.vcu; S.A = (const char*)(ws + WS_HID); S.Bt = (const char*)(ws + WS_WD); S.a_rb_bytes = (size_t)256 * FF; S.b_e_bytes = (size_t)DM * FF; S.b_pn_bytes = (size_t)256 * FF; S.list = (const int*)(ws + WS_LIST);
            EpiScatter E{(const int*)(ws + WS_LIST), ws + WS_Y};
            pg8::gemm_phase<EpiScatter, MoeOrder<false>, true, true, true>(F.lds + RING_OFF, FF / 2, S, E, F.tid);
            if (BOTH(11)) GRID_BAR();
        }
    }
    if (IN(12)) {
        PH_CTX();
        const unsigned char* Y = ws + WS_Y; const float* TW = (const float*)(ws + WS_TOKW); const f32x4* gf = (const f32x4*)KARG_IN(18) + F.lane; const f32x4* gn = (const f32x4*)KARG_IN(10) + F.lane;
        bool poison = (__hip_atomic_load(F.ctl + CW_TMO, RLX_AGENT) != 0u);
        if (N_LAUNCHES != PER_PHASE) for (int li = 0; li < N_LAUNCHES; ++li) poison |= __hip_atomic_load(F.ctl + CW_BAR + li * XCD_BAR_WORDS + XB_TMO, RLX_AGENT) != 0u;
        f32x4 ign[8], gfin[8];
#pragma unroll
        for (int j = 0; j < 8; ++j) { const f32x4 gg = gn[64 * j]; ign[j] = (f32x4){__builtin_amdgcn_rcpf(gg.x), __builtin_amdgcn_rcpf(gg.y), __builtin_amdgcn_rcpf(gg.z), __builtin_amdgcn_rcpf(gg.w)}; gfin[j] = gf[64 * j]; }
        for (int m0_ = gw; m0_ < T * REP_P12; m0_ += NGW) { const int m = m0_ % T;
            const u32x2* hr = (const u32x2*)(H + (size_t)m * DM) + F.lane; const unsigned* y0 = (const unsigned*)(Y + (size_t)(2 * m) * DM) + F.lane; const unsigned* y1 = (const unsigned*)(Y + (size_t)(2 * m + 1) * DM) + F.lane;
            f32x4* orow = (f32x4*)(F.out + (size_t)m * DM) + F.lane;
            const float w0 = TW[2 * m], w1 = TW[2 * m + 1];
            f32x4 v[8]; float s = 0.f;
#pragma unroll
            for (int j = 0; j < 8; ++j) { const u32x2 hv = hr[64 * j]; const unsigned a = y0[64 * j], b = y1[64 * j]; const f32x4 ig = ign[j];
                const f32x2 a01 = __builtin_amdgcn_cvt_pk_f32_fp8((int)a, false), a23 = __builtin_amdgcn_cvt_pk_f32_fp8((int)a, true), b01 = __builtin_amdgcn_cvt_pk_f32_fp8((int)b, false), b23 = __builtin_amdgcn_cvt_pk_f32_fp8((int)b, true);
                v[j].x = bf_lo(hv.x) * ig.x + w0 * a01[0] + w1 * b01[0]; v[j].y = bf_hi(hv.x) * ig.y + w0 * a01[1] + w1 * b01[1];
                v[j].z = bf_lo(hv.y) * ig.z + w0 * a23[0] + w1 * b23[0]; v[j].w = bf_hi(hv.y) * ig.w + w0 * a23[1] + w1 * b23[1];
                s += (v[j].x * v[j].x + v[j].y * v[j].y) + (v[j].z * v[j].z + v[j].w * v[j].w); }
            const float rstd = 1.0f / sqrtf(wave_sum(s) * (1.f / DM) + EPS);
#pragma unroll
            for (int j = 0; j < 8; ++j) { const f32x4 g = gfin[j]; f32x4 o = v[j] * rstd * g; if (poison) { const float qn = __builtin_nanf(""); o = (f32x4){qn, qn, qn, qn}; } orow[64 * j] = o; }
        }
    }
#undef IN
#undef BOTH
#undef GRID_BAR
}

extern "C" void kernel_launch(void* const* d_in, const int* in_sizes, int n_in, void* d_out, int out_size, void* d_ws, size_t ws_size, hipStream_t stream) {
    static int grid = 0;
    if (grid == 0) {
        if (n_in != 19 || in_sizes[0] != T * DM || out_size != T * DM || ws_size < WS_END) { fprintf(stderr, "kernel_launch: unexpected shapes (n_in %d, in0 %d, out %d, ws %zu < %zu?); nothing launched\n", n_in, n_in > 0 ? in_sizes[0] : -1, out_size, ws_size, (size_t)WS_END); grid = -1; return; }
        int dev = 0, cus = 0, per_cu = 0;
        if (hipGetDevice(&dev) != hipSuccess || hipDeviceGetAttribute(&cus, hipDeviceAttributeMultiprocessorCount, dev) != hipSuccess) { fprintf(stderr, "kernel_launch: device query failed\n"); grid = -1; return; }
        if (hipFuncSetAttribute((const void*)fwd_kernel, hipFuncAttributeMaxDynamicSharedMemorySize, LDS_BYTES) != hipSuccess) { fprintf(stderr, "kernel_launch: hipFuncSetAttribute failed\n"); grid = -1; return; }
        if (hipOccupancyMaxActiveBlocksPerMultiprocessor(&per_cu, (const void*)fwd_kernel, NWAVES * 64, LDS_BYTES) != hipSuccess || per_cu < 1)
            fprintf(stderr, "kernel_launch: note: occupancy query reports %d workgroups per CU\n", per_cu);
        (void)hipGetLastError();
        grid = cus;
    }
    if (grid < 0) return;
    if (hipMemsetAsync((char*)d_ws + WS_CTL, 0, CTL_ZERO_BYTES, stream) != hipSuccess) { fprintf(stderr, "kernel_launch: memset failed\n"); return; }
    Args a{};
    for (int i = 0; i < 19; ++i) a.in[i] = (const float*)d_in[i];
    a.out = (float*)d_out; a.ws = (unsigned char*)d_ws;
    static_assert(N_LAUNCHES == 1 || N_LAUNCHES == PER_PHASE, "MK_N_LAUNCHES: 1 or 13");
    for (int li = 0; li < N_LAUNCHES; ++li) {
        a.ph_lo = (N_LAUNCHES == PER_PHASE) ? li : 0; a.ph_hi = (N_LAUNCHES == PER_PHASE) ? li + 1 : PER_PHASE; a.li = (N_LAUNCHES == PER_PHASE) ? 0 : li;
        hipLaunchKernelGGL(fwd_kernel, dim3(grid), dim3(NWAVES * 64), LDS_BYTES, stream, a);
        const hipError_t le = hipPeekAtLastError();
        if (le != hipSuccess) { fprintf(stderr, "kernel_launch: launch %d failed: %s\n", li, hipGetErrorName(le)); break; }
    }
}
```

```cpp
#include <hip/hip_runtime.h>
#include <cstdio>
#include <cstdint>
#include <cstddef>

#ifndef REP_GEMM
#define REP_GEMM 0
#endif
#ifndef REP_MOE
#define REP_MOE 1
#endif
#ifndef REP_ATT
#define REP_ATT 1
#endif
#ifndef REP_SGU
#define REP_SGU 1
#endif
#ifndef REP_P7
#define REP_P7 1
#endif
#ifndef REP_P0
#define REP_P0 1
#endif
#ifndef REP_P12
#define REP_P12 1
#endif
#ifndef REP_A2
#define REP_A2 1
#endif
#ifndef ATT_CLAMP
#define ATT_CLAMP 0
#endif
#ifndef ATT_SUB
#define ATT_SUB 2
#endif
#ifndef ATT_STAGE
#define ATT_STAGE 3
#endif
#ifndef NT8
#define NT8 28
#endif
#ifndef MK_N_LAUNCHES
#define MK_N_LAUNCHES 1
#endif

#define LAS __attribute__((address_space(3)))
#define GAS __attribute__((address_space(1)))
typedef unsigned short bf16_t;
typedef short bf16x8 __attribute__((ext_vector_type(8)));
typedef short s16x4 __attribute__((ext_vector_type(4)));
typedef float f32x4 __attribute__((ext_vector_type(4)));
typedef float f32x2 __attribute__((ext_vector_type(2)));
typedef float f32x16 __attribute__((ext_vector_type(16)));
typedef unsigned u32x4 __attribute__((ext_vector_type(4)));
typedef unsigned u32x2 __attribute__((ext_vector_type(2)));

constexpr int BATCH = 8, SEQ = 4096, DM = 2048, T = BATCH * SEQ;
constexpr int NH = 8, HD = 128, DA = 1024, DS = 1024, NPROJ = 9216;
constexpr int MOBA_BLK = 256, NBLK = SEQ / MOBA_BLK;
constexpr int SGU_CHUNK = 128, SGU_G = 8;
constexpr int NE = 32, NEG = 4, EPG = 8, FF = 1024, NASSIGN = 2 * T;
constexpr int MAXRB = NASSIGN / 256 + NE;
constexpr float EPS = 1e-6f;

__device__ __forceinline__ unsigned cvt_pk_bf16(float lo, float hi) { unsigned r; asm volatile("v_cvt_pk_bf16_f32 %0, %1, %2" : "=v"(r) : "v"(lo), "v"(hi)); return r; }
__device__ __forceinline__ float bf_lo(unsigned w) { return __uint_as_float(w << 16); }
__device__ __forceinline__ float bf_hi(unsigned w) { return __uint_as_float(w & 0xffff0000u); }
__device__ __forceinline__ float sigmoid_f(float x) { return __builtin_amdgcn_rcpf(1.0f + __builtin_amdgcn_exp2f(-1.4426950408889634f * x)); }
__device__ __forceinline__ float gelu_tanh_f(float x) { const float y = 1.5957691216057308f * (x + 0.044715f * x * x * x); return x * sigmoid_f(y); }
__device__ __forceinline__ float silu_f(float x) { return x * sigmoid_f(x); }

namespace pg8 {
constexpr int BM = 256, BK = 64, HALF = 128, HTB = HALF * BK * 2  , STAGE_BYTES = 8 * HTB;
__host__ __device__ __forceinline__ int lds_byte(int r, int c) { const int st = (r >> 4) * 2 + (c >> 5), rr = r & 15, cc = c & 31, ob = rr * 64 + cc * 2; return st * 1024 + (ob ^ (((ob >> 9) & 1) << 5)); }
__host__ __device__ __forceinline__ void stage_rc(int b, int& R, int& C) { const int st = b / 1024, sb = b % 1024, swz = sb ^ (((sb >> 9) & 1) << 5); R = (st >> 1) * 16 + swz / 64; C = (st & 1) * 32 + (swz % 64) / 2; }
__host__ __device__ __forceinline__ int perm32(int rho) { const int n = rho >> 4, i = rho & 15; return 8 * (i >> 2) + 4 * n + (i & 3); }

typedef int i32x8 __attribute__((ext_vector_type(8)));
typedef int i32x4 __attribute__((ext_vector_type(4)));
__device__ __forceinline__ i32x8 cat8(bf16x8 a, bf16x8 b) { return __builtin_shufflevector(__builtin_bit_cast(i32x4, a), __builtin_bit_cast(i32x4, b), 0, 1, 2, 3, 4, 5, 6, 7); }
struct Unit { int pm, pn; const char* A; const char* B; int x0, x1, x2; };

template <class Epi, class Sched, bool ALIGN_EPI, bool SP2, bool FP8 = false>
__device__ __forceinline__ void gemm_phase(LAS unsigned char* lds, const int K, const Sched& S, const Epi& E, const int tid) {
    const int wid = __builtin_amdgcn_readfirstlane(tid >> 6), lane = tid & 63, wr = wid >> 2, wc = wid & 3, fr = lane & 15, fq = lane >> 4;
    const int nt = K / BK;
    constexpr bool GATHER = Sched::GATHER;
    unsigned vA[2][2], voffB[2]; int RA[2], CA[2];
#pragma unroll
    for (int i = 0; i < 2; ++i) { int R, C; stage_rc(tid * 16 + i * 8192, R, C); const int Rb = Epi::PERM ? ((R & ~31) + perm32(R & 31)) : R;
        RA[i] = R; CA[i] = C * 2; voffB[i] = (unsigned)(Rb * K + C) * 2u;
        vA[0][i] = (unsigned)(R * K + C) * 2u; vA[1][i] = (unsigned)((R + HALF) * K + C) * 2u; }
    const size_t kstep = (size_t)(BK * 2);
    const size_t hstep = (size_t)HALF * K * 2;
    const unsigned ldsw = (unsigned)wid * 1024u;
    const int aoff = lds_byte(wr * 64 + fr, fq * 8), boff = lds_byte(wc * 32 + fr, fq * 8);
#define PG8_SA(b, h) (((b) * 2 + (h)) * HTB)
#define PG8_SB(b, h) ((4 + (b) * 2 + (h)) * HTB)
#define PG8_STAGE(bufoff, gbase, voff) do { _Pragma("unroll") for (int _i = 0; _i < 2; ++_i) \
        __builtin_amdgcn_global_load_lds((const unsigned*)((const char*)(gbase) + (voff)[_i]), (LAS unsigned*)(lds + (bufoff) + ldsw + _i * 8192), 16, 0, 0); } while (0)
#define PG8_LDA(dst, b, h) do { _Pragma("unroll") for (int m = 0; m < 4; ++m) _Pragma("unroll") for (int k = 0; k < 2; ++k) dst[m][k] = *(const LAS bf16x8*)(lds + PG8_SA(b, h) + aoff + m * 2048 + k * 1024); } while (0)
#define PG8_LDB(dst, b, h) do { _Pragma("unroll") for (int n = 0; n < 2; ++n) _Pragma("unroll") for (int k = 0; k < 2; ++k) dst[n][k] = *(const LAS bf16x8*)(lds + PG8_SB(b, h) + boff + n * 2048 + k * 1024); } while (0)
#define PG8_MMA(ai, bj, At, Bt) do { __builtin_amdgcn_s_setprio(1); _Pragma("unroll") for (int m = 0; m < 4; ++m) _Pragma("unroll") for (int n = 0; n < 2; ++n) { \
        if constexpr (FP8) { asm volatile("v_mfma_scale_f32_16x16x128_f8f6f4 %0, %1, %2, %0, %3, %4 op_sel_hi:[0,0,0]" : "+v"(acc[ai][bj][m][n]) : "v"(cat8(Bt[n][0], Bt[n][1])), "v"(cat8(At[m][0], At[m][1])), "v"(sc_w), "v"(sc_a)); } \
        else { _Pragma("unroll") for (int k = 0; k < 2; ++k) acc[ai][bj][m][n] = __builtin_amdgcn_mfma_f32_16x16x32_bf16(Bt[n][k], At[m][k], acc[ai][bj][m][n], 0, 0, 0); } } __builtin_amdgcn_s_setprio(0); } while (0)
#define PG8_WAIT_V(n) asm volatile("s_waitcnt vmcnt(" #n ")" ::: "memory")
#define PG8_WAIT_L(n) asm volatile("s_waitcnt lgkmcnt(" #n ")" ::: "memory")
#define PG8_BAR __builtin_amdgcn_s_barrier()
#define PG8_SCHED __builtin_amdgcn_sched_barrier(0)
    Unit cur, nxt; int ui = 0;
    if (!S.next(0, cur)) return;
    f32x4 acc[2][2][4][2];
#pragma unroll
    for (int a = 0; a < 2; ++a)
#pragma unroll
        for (int b = 0; b < 2; ++b)
#pragma unroll
            for (int m = 0; m < 4; ++m)
#pragma unroll
                for (int n = 0; n < 2; ++n) acc[a][b][m][n] = (f32x4){0.f, 0.f, 0.f, 0.f};
    bf16x8 At[4][2], B0[2][2], B1[2][2];
    int sc_w = 0x7A7A7A7A, sc_a = 0x7F7F7F7F;
    if constexpr (FP8) asm volatile("" : "+v"(sc_w), "+v"(sc_a));
    const char* cA = cur.A; const char* cB = cur.B;
    if constexpr (GATHER) {
#pragma unroll
        for (int h = 0; h < 2; ++h)
#pragma unroll
            for (int i = 0; i < 2; ++i) vA[h][i] = S.row_off(cur, 0, h * HALF + RA[i]) + (unsigned)CA[i];
    }
    if constexpr (SP2) {
        PG8_STAGE(PG8_SB(0, 0), cB, voffB); PG8_STAGE(PG8_SB(0, 1), cB + hstep, voffB); PG8_STAGE(PG8_SA(0, 0), cA, vA[0]); PG8_STAGE(PG8_SA(0, 1), cA, vA[1]);
        if (wr == 1) PG8_BAR;
        PG8_WAIT_V(2); PG8_BAR;
        PG8_STAGE(PG8_SB(1, 0), cB + kstep, voffB); PG8_STAGE(PG8_SA(1, 0), cA + kstep, vA[0]); PG8_STAGE(PG8_SB(1, 1), cB + hstep + kstep, voffB);
        PG8_WAIT_V(6); PG8_BAR;
    } else {
        PG8_STAGE(PG8_SB(0, 0), cB, voffB); PG8_STAGE(PG8_SA(0, 0), cA, vA[0]); PG8_STAGE(PG8_SB(0, 1), cB + hstep, voffB); PG8_STAGE(PG8_SA(0, 1), cA, vA[1]);
        if (wr == 1) PG8_BAR;
        PG8_WAIT_V(4); PG8_BAR;
        PG8_STAGE(PG8_SB(1, 0), cB + kstep, voffB); PG8_STAGE(PG8_SA(1, 0), cA + kstep, vA[0]); PG8_STAGE(PG8_SB(1, 1), cB + hstep + kstep, voffB);
        PG8_WAIT_V(6); PG8_BAR;
    }
    for (;;) {
        const bool has_next = S.next(ui + 1, nxt);
        const char* nA = has_next ? nxt.A : cA; const char* nB = has_next ? nxt.B : cB;
        for (int t = 0; t < nt; t += 2) {
            const bool last = (t == nt - 2);
            const char* a1 = cA + (size_t)(t + 1) * kstep;
            const char* a2 = last ? nA : cA + (size_t)(t + 2) * kstep; const char* b2 = last ? nB : cB + (size_t)(t + 2) * kstep;
            const char* a3 = a2 + kstep; const char* b3 = b2 + kstep;
            unsigned vNx[2][2];
            if constexpr (GATHER) {
                if (last && has_next) { int t2 = tid; asm volatile("" : "+v"(t2));
#pragma unroll
                    for (int i = 0; i < 2; ++i) { int R2, C2; stage_rc(t2 * 16 + i * 8192, R2, C2);
#pragma unroll
                        for (int h = 0; h < 2; ++h) vNx[h][i] = S.row_off(nxt, ui + 1, h * HALF + R2) + (unsigned)(C2 * 2); }
                }
            }
#define PG8_SWITCH() do { if constexpr (GATHER) { if (last && has_next) { _Pragma("unroll") for (int h = 0; h < 2; ++h) _Pragma("unroll") for (int i = 0; i < 2; ++i) vA[h][i] = vNx[h][i]; } } } while (0)
            if constexpr (SP2) {
            PG8_LDB(B0, 0, 0); PG8_LDB(B1, 0, 1); PG8_SCHED; PG8_LDA(At, 0, 0); PG8_STAGE(PG8_SA(1, 1), a1, vA[1]); PG8_SWITCH();
            PG8_WAIT_V(8); PG8_WAIT_L(0); PG8_BAR; PG8_MMA(0, 0, At, B0); PG8_MMA(0, 1, At, B1); PG8_BAR; PG8_SCHED;
            PG8_LDA(At, 0, 1); PG8_STAGE(PG8_SB(0, 0), b2, voffB); PG8_STAGE(PG8_SB(0, 1), b2 + hstep, voffB); PG8_STAGE(PG8_SA(0, 0), a2, vA[0]);
            PG8_WAIT_V(8); PG8_WAIT_L(0); PG8_BAR; PG8_MMA(1, 0, At, B0); PG8_MMA(1, 1, At, B1); PG8_BAR; PG8_SCHED;
            PG8_LDB(B0, 1, 0); PG8_LDB(B1, 1, 1); PG8_SCHED; PG8_LDA(At, 1, 0); PG8_STAGE(PG8_SA(0, 1), a2, vA[1]);
            PG8_WAIT_V(8); PG8_WAIT_L(0); PG8_BAR; PG8_MMA(0, 0, At, B0); PG8_MMA(0, 1, At, B1); PG8_BAR; PG8_SCHED;
            PG8_LDA(At, 1, 1); PG8_STAGE(PG8_SB(1, 0), b3, voffB); PG8_STAGE(PG8_SB(1, 1), b3 + hstep, voffB); PG8_STAGE(PG8_SA(1, 0), a3, vA[0]);
            PG8_WAIT_V(8); PG8_WAIT_L(0); PG8_BAR; PG8_MMA(1, 0, At, B0); PG8_MMA(1, 1, At, B1); PG8_BAR; PG8_SCHED;
            } else {
            PG8_LDB(B0, 0, 0); PG8_SCHED; PG8_LDA(At, 0, 0); PG8_STAGE(PG8_SA(1, 1), a1, vA[1]); PG8_SWITCH();
            PG8_WAIT_L(8); PG8_BAR; PG8_WAIT_L(0); PG8_MMA(0, 0, At, B0); PG8_BAR; PG8_SCHED;
            PG8_LDB(B1, 0, 1); PG8_STAGE(PG8_SB(0, 0), b2, voffB);
            PG8_BAR; PG8_WAIT_L(0); PG8_MMA(0, 1, At, B1); PG8_BAR;
            PG8_LDA(At, 0, 1); PG8_STAGE(PG8_SA(0, 0), a2, vA[0]);
            PG8_BAR; PG8_WAIT_L(0); PG8_MMA(1, 0, At, B0); PG8_BAR; PG8_SCHED;
            PG8_STAGE(PG8_SB(0, 1), b2 + hstep, voffB);
            PG8_WAIT_V(6); PG8_BAR; PG8_MMA(1, 1, At, B1); PG8_BAR;
            PG8_LDB(B0, 1, 0); PG8_SCHED; PG8_LDA(At, 1, 0); PG8_STAGE(PG8_SA(0, 1), a2, vA[1]);
            PG8_WAIT_L(8); PG8_BAR; PG8_WAIT_L(0); PG8_MMA(0, 0, At, B0); PG8_BAR; PG8_SCHED;
            PG8_LDB(B1, 1, 1); PG8_STAGE(PG8_SB(1, 0), b3, voffB);
            PG8_BAR; PG8_WAIT_L(0); PG8_MMA(0, 1, At, B1); PG8_BAR;
            PG8_LDA(At, 1, 1); PG8_STAGE(PG8_SA(1, 0), a3, vA[0]);
            PG8_BAR; PG8_WAIT_L(0); PG8_MMA(1, 0, At, B0); PG8_BAR; PG8_SCHED;
            PG8_STAGE(PG8_SB(1, 1), b3 + hstep, voffB);
            PG8_WAIT_V(6); PG8_BAR; PG8_MMA(1, 1, At, B1); PG8_BAR;
            }
        }
        if constexpr (ALIGN_EPI) { if (wr == 0) PG8_BAR; }
        if constexpr (FP8) asm volatile("s_nop 15\n\ts_nop 15" ::: "memory");
        E(acc, cur, wr, wc, fr, fq);
        if (!has_next) break;
#pragma unroll
        for (int a = 0; a < 2; ++a)
#pragma unroll
            for (int b = 0; b < 2; ++b)
#pragma unroll
                for (int m = 0; m < 4; ++m)
#pragma unroll
                    for (int n = 0; n < 2; ++n) acc[a][b][m][n] = (f32x4){0.f, 0.f, 0.f, 0.f};
        cur = nxt; cA = nA; cB = nB; ++ui;
        if constexpr (ALIGN_EPI) { if (wr == 1) PG8_BAR; }
    }
    PG8_WAIT_V(0);
    if constexpr (!ALIGN_EPI) { if (wr == 0) PG8_BAR; }
    PG8_BAR;
#undef PG8_SA
#undef PG8_SB
#undef PG8_STAGE
#undef PG8_LDA
#undef PG8_LDB
#undef PG8_MMA
#undef PG8_WAIT_V
#undef PG8_WAIT_L
#undef PG8_BAR
#undef PG8_SCHED
#undef PG8_SWITCH
}

constexpr int NXCD = 8, WGM = 8;
struct DenseOrder {
    static constexpr bool GATHER = false;
    const char* A; const char* Bt; int K, nM, nN, nwg, G, c, reps, skip_from, skip_len;
    __device__ __forceinline__ void init(const void* A_, const void* Bt_, int M, int N, int K_, int G_, int c_, int reps_ = 1, int skip_from_ = 1 << 20, int skip_len_ = 0) { A = (const char*)A_; Bt = (const char*)Bt_; K = K_; nM = M / BM; nN = N / BM; nwg = nM * nN; G = G_; c = c_; reps = reps_; skip_from = skip_from_; skip_len = skip_len_; }
    __device__ __forceinline__ bool next(int i, Unit& u) const {
        const long L = (long)i * G + c; if (L >= (long)nwg * reps) return false;
        int wgid = (int)(L % nwg); { const int q = nwg / NXCD, r = nwg % NXCD, xcd = wgid % NXCD, off = wgid / NXCD; wgid = (xcd < r ? xcd * (q + 1) : r * (q + 1) + (xcd - r) * q) + off; }
        const int nig = WGM * nN, gid = wgid / nig, fm = gid * WGM, gsz = (nM - fm) < WGM ? (nM - fm) : WGM;
        u.pm = fm + ((wgid % nig) % gsz); u.pn = (wgid % nig) / gsz; if (u.pn >= skip_from) u.pn += skip_len;
        u.A = A + (size_t)u.pm * BM * K * 2; u.B = Bt + (size_t)u.pn * BM * K * 2; u.x0 = 0; u.x1 = 0; u.x2 = (L >= nwg) ? 1 : 0; return true;
    }
    __device__ __forceinline__ unsigned row_off(const Unit&, int, int) const { return 0u; }
};
}

namespace att {
constexpr int D = 128, LD = 1024, NW = 8, QBLK = 32, KVBLK = 64, QB = 256;
constexpr int SHM_V = KVBLK * D * 2, SHM_K = KVBLK * D * 2;
constexpr int LDS_BYTES = 2 * SHM_V + 2 * SHM_K + NW * 64 * 4;
constexpr float SCALE = 0.08838834764831845f, THR = 8.f;
#define KSWZ(row, colB) ((((colB) >> 7) * 8192) + (row) * 128 + (((colB) & 127) ^ (((((row) >> 1) & 1) | ((((row) >> 3) & 3) << 1)) << 4)))
#define KROW32 (32 * 128)
#define SBAR() __builtin_amdgcn_sched_barrier(0)
__device__ __forceinline__ int v_st(int k, int c) { const int kk = (k & ~0xC) | ((k & 4) << 1) | ((k & 8) >> 1); return ((kk >> 3) * 4 + (c >> 5)) * 512 + ((kk & 7) * 32 + (c & 31)) * 2; }
__device__ __forceinline__ int v_rd_base(int lane) { return ((lane & 3) << 3) | (((lane >> 2) & 3) << 6) | (((lane >> 4) & 1) << 5) | (((lane >> 5) & 1) << 8); }
constexpr int v_rd_off(int d0, int ks, int half) { return d0 * 512 + ks * 4096 + half * 2048; }
__device__ __forceinline__ int crow(int r, int hi) { return (r & 3) + 8 * (r >> 2) + 4 * hi; }
__device__ __forceinline__ bf16x8 load8(const bf16_t* p) { return *reinterpret_cast<const bf16x8*>(p); }
__device__ __forceinline__ void mask_causal(f32x16& p0, f32x16& p1, int dq) {
    const float NEG = -__builtin_inff();
#pragma unroll
    for (int r = 0; r < 16; ++r) { const int c = (r & 3) + 8 * (r >> 2); if (dq - c < 0) p0[r] = NEG; if (dq - c - 32 < 0) p1[r] = NEG; }
}
__device__ __forceinline__ void mask_all(f32x16& p0, f32x16& p1, bool keep) {
    const float NEG = -__builtin_inff();
#pragma unroll
    for (int r = 0; r < 16; ++r) { p0[r] = keep ? p0[r] : NEG; p1[r] = keep ? p1[r] : NEG; }
}
__device__ __forceinline__ void partialSM(f32x16& p0, f32x16& p1, float& m_reg, float& mn, float& alpha) {
    float pmax = p0[0];
#pragma unroll
    for (int r = 1; r < 16; ++r) pmax = fmaxf(pmax, p0[r]);
#pragma unroll
    for (int r = 0; r < 16; ++r) pmax = fmaxf(pmax, p1[r]);
    { auto rr = __builtin_amdgcn_permlane32_swap(__float_as_uint(pmax), __float_as_uint(pmax), false, false);
      pmax = fmaxf(__uint_as_float(rr[0]), __uint_as_float(rr[1])); }
    constexpr float C2 = 1.4426950408889634f * SCALE;
    if (__builtin_expect(__all((pmax - m_reg) * SCALE <= THR), 1)) { mn = m_reg; alpha = 1.f; }
    else { mn = fmaxf(m_reg, pmax); alpha = __builtin_amdgcn_exp2f((m_reg - mn) * C2); m_reg = mn; }
    const float mnL = -mn * C2;
#pragma unroll
    for (int r = 0; r < 16; ++r) p0[r] = fmaf(p0[r], C2, mnL);
#pragma unroll
    for (int r = 0; r < 16; ++r) p1[r] = fmaf(p1[r], C2, mnL);
#pragma unroll
    for (int r = 0; r < 16; ++r) p0[r] = __builtin_amdgcn_exp2f(p0[r]);
}
__device__ __forceinline__ void finishSM(f32x16& p0, f32x16& p1, float alpha, float& l_reg, bf16x8& pa0, bf16x8& pa1, bf16x8& pa2, bf16x8& pa3) {
#pragma unroll
    for (int r = 0; r < 16; ++r) p1[r] = __builtin_amdgcn_exp2f(p1[r]);
    float ps = 0;
#pragma unroll
    for (int r = 0; r < 16; ++r) ps += p0[r];
#pragma unroll
    for (int r = 0; r < 16; ++r) ps += p1[r];
    { auto rr = __builtin_amdgcn_permlane32_swap(__float_as_uint(ps), __float_as_uint(ps), false, false);
      ps = __uint_as_float(rr[0]) + __uint_as_float(rr[1]); }
    l_reg = l_reg * alpha + ps;
#define PK4(P, B_, OUT) do { unsigned a0 = cvt_pk_bf16(P[B_+0], P[B_+1]), a1 = cvt_pk_bf16(P[B_+2], P[B_+3]);                          \
        unsigned b0 = cvt_pk_bf16(P[B_+4], P[B_+5]), b1 = cvt_pk_bf16(P[B_+6], P[B_+7]);                                             \
        auto r0 = __builtin_amdgcn_permlane32_swap(a0, b0, false, false); auto r1 = __builtin_amdgcn_permlane32_swap(a1, b1, false, false); \
        u32x4 w = {r0[0], r1[0], r0[1], r1[1]}; OUT = *reinterpret_cast<bf16x8*>(&w); } while (0)
    PK4(p0, 0, pa0); PK4(p0, 8, pa1); PK4(p1, 0, pa2); PK4(p1, 8, pa3);
#undef PK4
}
template <int KB>
__device__ __forceinline__ void qkt(f32x16& p0, f32x16& p1, const char* K_lds, int r32, int hi, const bf16x8* qr) {
    p0 = f32x16{}; p1 = f32x16{};
    const char* kb[4];
#pragma unroll
    for (int dd = 0; dd < 4; ++dd) kb[dd] = K_lds + KB * SHM_K + KSWZ(r32, (dd * 16 + hi * 8) * 2);
#pragma unroll
    for (int d0 = 0; d0 < 8; ++d0) { const char* a = kb[d0 & 3] + (d0 >> 2) * 8192;
        bf16x8 b0 = *reinterpret_cast<const bf16x8*>(a);
        bf16x8 b1 = *reinterpret_cast<const bf16x8*>(a + KROW32);
        p0 = __builtin_amdgcn_mfma_f32_32x32x16_bf16(b0, qr[d0], p0, 0, 0, 0);
        p1 = __builtin_amdgcn_mfma_f32_32x32x16_bf16(b1, qr[d0], p1, 0, 0, 0); }
}
template <int VB>
__device__ __forceinline__ void pv_tile(f32x16* o, int vb0, bf16x8 pa0, bf16x8 pa1, bf16x8 pa2, bf16x8 pa3) {
#define TRRD(dst, off) asm volatile("ds_read_b64_tr_b16 %0, %1 offset:%2" : "=&v"(dst) : "v"(vb0), "i"(off) : "memory")
#define PV_RD(S_, d0) do { constexpr int b_ = VB * SHM_V + v_rd_off(d0, 0, 0); \
        TRRD(S_[0], b_); TRRD(S_[1], b_ + 2048); TRRD(S_[2], b_ + 4096); TRRD(S_[3], b_ + 6144); TRRD(S_[4], b_ + 8192); TRRD(S_[5], b_ + 10240); TRRD(S_[6], b_ + 12288); TRRD(S_[7], b_ + 14336); } while (0)
#define PV_MF(S_, d0) do { \
        o[d0] = __builtin_amdgcn_mfma_f32_32x32x16_bf16(pa0, (bf16x8){S_[0][0], S_[0][1], S_[0][2], S_[0][3], S_[1][0], S_[1][1], S_[1][2], S_[1][3]}, o[d0], 0, 0, 0);   \
        o[d0] = __builtin_amdgcn_mfma_f32_32x32x16_bf16(pa1, (bf16x8){S_[2][0], S_[2][1], S_[2][2], S_[2][3], S_[3][0], S_[3][1], S_[3][2], S_[3][3]}, o[d0], 0, 0, 0);   \
        o[d0] = __builtin_amdgcn_mfma_f32_32x32x16_bf16(pa2, (bf16x8){S_[4][0], S_[4][1], S_[4][2], S_[4][3], S_[5][0], S_[5][1], S_[5][2], S_[5][3]}, o[d0], 0, 0, 0);   \
        o[d0] = __builtin_amdgcn_mfma_f32_32x32x16_bf16(pa3, (bf16x8){S_[6][0], S_[6][1], S_[6][2], S_[6][3], S_[7][0], S_[7][1], S_[7][2], S_[7][3]}, o[d0], 0, 0, 0); } while (0)
    s16x4 fa[8], fb[8];
    PV_RD(fa, 0);
    PV_RD(fb, 1); asm volatile("s_waitcnt lgkmcnt(8)" ::: "memory"); SBAR(); PV_MF(fa, 0); SBAR();
    PV_RD(fa, 2); asm volatile("s_waitcnt lgkmcnt(8)" ::: "memory"); SBAR(); PV_MF(fb, 1); SBAR();
    PV_RD(fb, 3); asm volatile("s_waitcnt lgkmcnt(8)" ::: "memory"); SBAR(); PV_MF(fa, 2); SBAR();
    asm volatile("s_waitcnt lgkmcnt(0)" ::: "memory"); SBAR(); PV_MF(fb, 3);
#undef PV_RD
#undef PV_MF
#undef TRRD
}
constexpr int WS_OFF = 2 * SHM_V + 2 * SHM_K;
constexpr int OST_OFF = WS_OFF + NW * 1024;
constexpr int LDS_BYTES2 = OST_OFF + NW * 8192;
constexpr int LCAP = 3840;
struct URef { unsigned qoff, koff; int key0; unsigned lbase; int rows; unsigned pbase; };
struct Bases { unsigned char* wsb; unsigned oQ, oK, oV, oO, oPART, oPML, oALIST; };
struct Seam { bf16x8 qr[8]; bf16x8 st_v0, st_v1, st_k0, st_k1; unsigned ent; };
#define LDG8(boff) (*(const bf16x8*)(BS.wsb + (ATT_CLAMP ? (((boff) < 0x3C000000u) ? (boff) : 0x3C000000u) : (boff))))
#define VMW() asm volatile("s_waitcnt vmcnt(0)" ::: "memory")
#define VMWN(n) asm volatile("s_waitcnt vmcnt(%0)" :: "i"(n) : "memory")
#define SLOAD_H(koff_, k0) do { const unsigned ko_ = ((koff_) + (unsigned)(k0) * LD) * 2u;     \
                         S.st_v0 = LDG8(BS.oV + ko_ + kl0); S.st_v1 = LDG8(BS.oV + ko_ + kl1); S.st_k0 = LDG8(BS.oK + ko_ + kl0); S.st_k1 = LDG8(BS.oK + ko_ + kl1); } while (0)
#define SWRITE_HK(bf) do { *(bf16x8*)(K_lds + (bf) * SHM_K + kws) = S.st_k0; *(bf16x8*)(K_lds + (bf) * SHM_K + kws + KROW32) = S.st_k1; } while (0)
#define SWRITE_HV(bf) do { *(bf16x8*)(V_lds + (bf) * SHM_V + vst0) = S.st_v0; *(bf16x8*)(V_lds + (bf) * SHM_V + vst1) = S.st_v1; } while (0)
#define SWRITE_H(bf) do { SWRITE_HV(bf); SWRITE_HK(bf); } while (0)
template <int MODE> __device__ __forceinline__ void q_loads(const Bases& BS, const URef& u, Seam& S, int wid, int r32, int hi) {
    unsigned ql;
    if constexpr (MODE == 1) { int row = wid * QBLK + r32; row = row < u.rows ? row : u.rows - 1; S.ent = *(const unsigned short*)(BS.wsb + (BS.oALIST + (ATT_CLAMP ? ((u.lbase + (unsigned)row) & 0x3FFFFFu) : (u.lbase + (unsigned)row)) * 2u)); ql = (unsigned)((S.ent & 4095u) * LD + hi * 8) * 2u; }
    else ql = (unsigned)((wid * QBLK + r32) * LD + hi * 8) * 2u;
    const unsigned qb_ = BS.oQ + u.qoff * 2u + ql;
#pragma unroll
    for (int d0 = 0; d0 < 8; ++d0) S.qr[d0] = LDG8(qb_ + d0 * 32);
}
template <int MODE> __device__ __forceinline__ void prime(const Bases& BS, const URef& cur, char* lds, Seam& S, const int tid) {
    const int wid = __builtin_amdgcn_readfirstlane(tid >> 6), lane = tid & 63, r32 = lane & 31, hi = lane >> 5;
    const int sr = tid >> 4, sc = (tid & 15) * 8, kws = KSWZ(sr, sc * 2); char* K_lds = lds + 2 * SHM_V;
    const unsigned kl0 = (unsigned)(sr * LD + sc) * 2u, kl1 = kl0 + 32u * LD * 2u;
    q_loads<MODE>(BS, cur, S, wid, r32, hi);
    SLOAD_H(cur.koff, cur.key0); VMW(); SWRITE_HK(0);
    __syncthreads();
}
__device__ __forceinline__ unsigned moba_select(const bf16x8* qr, const bf16_t* KM, int bq, int r32, int hi) {
    f32x16 g = f32x16{};
    const unsigned kml = (unsigned)((r32 & 15) * LD + hi * 8) * 2u;
#pragma unroll
    for (int d0 = 0; d0 < 8; ++d0) { const bf16x8 kf = *(const bf16x8*)((const char*)KM + (kml + d0 * 32));
        g = __builtin_amdgcn_mfma_f32_32x32x16_bf16(kf, qr[d0], g, 0, 0, 0); }
    float gv[16];
#pragma unroll
    for (int r = 0; r < 8; ++r) { auto rr = __builtin_amdgcn_permlane32_swap(__float_as_uint(g[r]), __float_as_uint(g[r]), false, false);
        gv[(r & 3) + 8 * (r >> 2)] = __uint_as_float(rr[0]); gv[(r & 3) + 8 * (r >> 2) + 4] = __uint_as_float(rr[1]); }
    const float NEG = -__builtin_inff();
#pragma unroll
    for (int j = 0; j < 16; ++j) gv[j] = (j < bq) ? gv[j] : NEG;
    unsigned sel = 0u;
#pragma unroll
    for (int it = 0; it < 3; ++it) { float best = NEG; int bi = -1;
#pragma unroll
        for (int j = 0; j < 16; ++j) { const bool gt = gv[j] > best; best = gt ? gv[j] : best; bi = gt ? j : bi; }
        sel |= (bi >= 0) ? (1u << bi) : 0u;
#pragma unroll
        for (int j = 0; j < 16; ++j) gv[j] = (j == bi) ? NEG : gv[j]; }
    return sel;
}
template <int MODE>
__device__ __forceinline__ void block(const Bases& BS, const URef& cur, const URef& nxt, char* lds, Seam& S, const int tid) {
    const int wid = __builtin_amdgcn_readfirstlane(tid >> 6), lane = tid & 63, r32 = lane & 31, hi = lane >> 5;
    constexpr int NT = 4;
    const int qlo = cur.key0 + wid * QBLK, qm = qlo + r32 - 4 * hi;
    char* V_lds = lds; char* K_lds = lds + 2 * SHM_V;
    float* ws = (float*)(lds + WS_OFF) + wid * 256; float* li_l = ws, * al_l = ws + 32; unsigned* entl = (unsigned*)(ws + 64); float* wts = ws + 96;
    char* ost = lds + OST_OFF + wid * 8192;
    float m_reg = -1e30f, l_reg = 0; f32x16 o[4] = {};
    const int sr = tid >> 4, sc = (tid & 15) * 8, vst0 = v_st(sr, sc), vst1 = v_st(32 + sr, sc), kws = KSWZ(sr, sc * 2);
    const unsigned kl0 = (unsigned)(sr * LD + sc) * 2u, kl1 = kl0 + 32u * LD * 2u;
    const int vb0 = (int)(uintptr_t)V_lds + v_rd_base(lane);
    if constexpr (MODE == 1) { if (hi == 0) entl[r32] = S.ent; }
#define RESC(a) do { if (__any((a) < 1.f)) { if (hi == 0) al_l[r32] = (a); asm volatile("s_waitcnt lgkmcnt(0)" ::: "memory");              \
                     for (int d_ = 0; d_ < 4; ++d_) for (int r = 0; r < 16; ++r) o[d_][r] *= al_l[crow(r, hi)]; } } while (0)
#define KBASE(t) (cur.key0 + (t) * KVBLK)
#define MASKT(P0_, P1_, t) do { if constexpr (MODE == 0) { const int kb_ = KBASE(t); if (kb_ + KVBLK - 1 > qlo) mask_causal(P0_, P1_, qm - kb_); } } while (0)
    constexpr int NQL = 8;
#define SEAM_K0() do { VMWN(NQL); SWRITE_HK(0); SBAR(); } while (0)
    f32x16 pA0, pA1, pB0, pB1; float mnA, mnB, alA, alB; bf16x8 pa0, pa1, pa2, pa3;
#if ATT_CLAMP >= 3
    if (true) { l_reg = 1.f; m_reg = 0.f; } else {
#else
    {
#endif
    SWRITE_HV(0); SBAR();
    SLOAD_H(cur.koff, KBASE(1));
    SBAR(); qkt<0>(pA0, pA1, K_lds, r32, hi, S.qr);
    MASKT(pA0, pA1, 0); partialSM(pA0, pA1, m_reg, mnA, alA);
    VMW(); SWRITE_H(1);
    __syncthreads();
#define HALF_STEP(PX0, PX1, mnX, alX, PY0, PY1, alY, t, KB, VB, SB) do {                                                      \
        SBAR(); qkt<KB>(PX0, PX1, K_lds, r32, hi, S.qr);                                             \
        finishSM(PY0, PY1, alY, l_reg, pa0, pa1, pa2, pa3); SBAR();                                                           \
        if ((t) + 1 < NT) { SLOAD_H(cur.koff, KBASE((t) + 1)); SBAR(); }                                               \
        pv_tile<VB>(o, vb0, pa0, pa1, pa2, pa3); MASKT(PX0, PX1, (t)); partialSM(PX0, PX1, m_reg, mnX, alX);                                        \
        __syncthreads();                                                                                                      \
        if ((t) + 1 < NT) { VMW(); SWRITE_H(SB); }                                                                          \
        RESC(alX); __syncthreads(); } while (0)
    HALF_STEP(pB0, pB1, mnB, alB, pA0, pA1, alA, 1, 1, 0, 0);
    HALF_STEP(pA0, pA1, mnA, alA, pB0, pB1, alB, 2, 0, 1, 1);
    { SBAR(); qkt<1>(pB0, pB1, K_lds, r32, hi, S.qr); SBAR(); }
    SLOAD_H(nxt.koff, nxt.key0); SBAR();
    q_loads<MODE>(BS, nxt, S, wid, r32, hi);
    SBAR();
    finishSM(pA0, pA1, alA, l_reg, pa0, pa1, pa2, pa3); SBAR();
    pv_tile<0>(o, vb0, pa0, pa1, pa2, pa3);
    { MASKT(pB0, pB1, NT - 1); partialSM(pB0, pB1, m_reg, mnB, alB); __syncthreads(); RESC(alB);
      finishSM(pB0, pB1, alB, l_reg, pa0, pa1, pa2, pa3); SBAR(); pv_tile<1>(o, vb0, pa0, pa1, pa2, pa3); }
    SBAR(); SEAM_K0();
    }
#if ATT_CLAMP == 4
    __syncthreads(); return;
#endif
    if (hi == 0) li_l[r32] = l_reg; asm volatile("s_waitcnt lgkmcnt(0)" ::: "memory");
    float rli[16];
#pragma unroll
    for (int r = 0; r < 16; ++r) rli[r] = __builtin_amdgcn_rcpf(li_l[crow(r, hi)]);
#pragma unroll
    for (int r = 0; r < 16; ++r) { const int orow = crow(r, hi);
#pragma unroll
        for (int d0 = 0; d0 < 4; ++d0) { const float v = o[d0][r] * rli[r];
            const float vn = __uint_as_float((unsigned)__builtin_amdgcn_update_dpp(0, (int)__float_as_uint(v), 0xB1, 0xF, 0xF, false));
            const unsigned pk = cvt_pk_bf16(v, vn);
            if ((r32 & 1) == 0) *(unsigned*)(ost + (orow * 128 + d0 * 32 + r32) * 2) = pk; } }
    constexpr float C2 = 1.4426950408889634f * SCALE;
    if constexpr (MODE == 1) {
        asm volatile("s_waitcnt lgkmcnt(0)" ::: "memory");
        if ((ATT_SUB >= 2) && hi == 0 && wid * QBLK + r32 < cur.rows) { const unsigned e = entl[r32]; *(f32x2*)(BS.wsb + (BS.oPML + (((cur.pbase + (e & 4095u)) * 3u + (e >> 12) - 1u) << 3))) = (f32x2){m_reg, l_reg}; }
#pragma unroll
        for (int i = 0; i < 8; ++i) { const int row = i * 4 + (lane >> 4), ch = lane & 15; const bf16x8 own = *(const bf16x8*)(ost + (row * 128 + ch * 8) * 2); const unsigned e = entl[row];
            if ((ATT_SUB >= 2) && (ATT_SUB != 4) && wid * QBLK + row < cur.rows) *(bf16x8*)(BS.wsb + (BS.oPART + ((((cur.pbase + (e & 4095u)) * 3u + (e >> 12) - 1u) << 8) + (unsigned)ch * 16u))) = own; }
    } else {
#if ATT_CLAMP == 2
        const int ns = 0;
#else
        const int ns = cur.rows;
#endif
        if (hi == 0) { const unsigned prow = (cur.pbase + (unsigned)(cur.key0 + wid * QBLK + r32)) * 3u; float mk[4], lk[4]; mk[0] = m_reg; lk[0] = l_reg;
#pragma unroll
            for (int s2 = 0; s2 < 3; ++s2) { if (s2 < ns) { const f32x2 t = *(const f32x2*)(BS.wsb + (BS.oPML + ((prow + (unsigned)s2) << 3))); mk[s2 + 1] = t[0]; lk[s2 + 1] = t[1]; } else { mk[s2 + 1] = -1e30f; lk[s2 + 1] = 0.f; } }
            const float M = fmaxf(fmaxf(mk[0], mk[1]), fmaxf(mk[2], mk[3])); float w[4], sum = 0.f;
#pragma unroll
            for (int k = 0; k < 4; ++k) { w[k] = lk[k] * __builtin_amdgcn_exp2f((mk[k] - M) * C2); sum += w[k]; }
            const float inv = __builtin_amdgcn_rcpf(sum);
#pragma unroll
            for (int k = 0; k < 4; ++k) wts[r32 * 4 + k] = w[k] * inv; }
        asm volatile("s_waitcnt lgkmcnt(0)" ::: "memory");
        const unsigned ow_ = BS.oO + cur.qoff + (unsigned)(wid * QBLK) * LD;
#pragma unroll
        for (int i = 0; i < 8; ++i) { const int row = i * 4 + (lane >> 4), ch = lane & 15; const u32x4 own = *(const u32x4*)(ost + (row * 128 + ch * 8) * 2);
            const f32x4 wv = *(const f32x4*)(wts + row * 4);
            float a8[8] = {bf_lo(own.x) * wv[0], bf_hi(own.x) * wv[0], bf_lo(own.y) * wv[0], bf_hi(own.y) * wv[0], bf_lo(own.z) * wv[0], bf_hi(own.z) * wv[0], bf_lo(own.w) * wv[0], bf_hi(own.w) * wv[0]};
            const unsigned pro_ = BS.oPART + (((cur.pbase + (unsigned)(cur.key0 + wid * QBLK + row)) * 3u) << 8) + (unsigned)ch * 16u;
#pragma unroll
            for (int s2 = 0; s2 < 3; ++s2) if (s2 < ns) { const u32x4 p = *(const u32x4*)(BS.wsb + (pro_ + (unsigned)s2 * 256u)); const float wk = wv[s2 + 1];
                a8[0] += bf_lo(p.x) * wk; a8[1] += bf_hi(p.x) * wk; a8[2] += bf_lo(p.y) * wk; a8[3] += bf_hi(p.y) * wk; a8[4] += bf_lo(p.z) * wk; a8[5] += bf_hi(p.z) * wk; a8[6] += bf_lo(p.w) * wk; a8[7] += bf_hi(p.w) * wk; }
            u32x2 w8; w8.x = __builtin_amdgcn_cvt_pk_fp8_f32(a8[2], a8[3], __builtin_amdgcn_cvt_pk_fp8_f32(a8[0], a8[1], 0u, false), true); w8.y = __builtin_amdgcn_cvt_pk_fp8_f32(a8[6], a8[7], __builtin_amdgcn_cvt_pk_fp8_f32(a8[4], a8[5], 0u, false), true);
            *(u32x2*)(BS.wsb + (ow_ + (unsigned)row * LD + (unsigned)ch * 8u)) = w8; }
    }
    __syncthreads();
#undef RESC
#undef KBASE
#undef MASKT
#undef SEAM_K0
#undef HALF_STEP
}
constexpr int R_V = 4 * SHM_K, R_WS = R_V + 4 * SHM_V, R_BYTES = R_WS + NW * 1024;
struct CRef { unsigned qoff; unsigned lbase; int rows; unsigned pbase; int qpos0; int ns; };
struct QState { bf16x8 qr[8]; unsigned ent; };
__device__ __forceinline__ int rb0(int wid) { return wid < 4 ? wid : 11 - wid; }
struct KVRegs { bf16x8 kk[4][2], vv[4][2]; };
__device__ __forceinline__ void load_kv_issue(const Bases& BS, unsigned koff, int key0, const int tid, KVRegs& R) {
    const int sr = tid >> 4, sc = (tid & 15) * 8;
    const unsigned kl0 = (unsigned)(sr * LD + sc) * 2u, kl1 = kl0 + 32u * LD * 2u;
#pragma unroll
    for (int t = 0; t < 4; ++t) { const unsigned ko_ = (koff + (unsigned)(key0 + t * KVBLK) * LD) * 2u;
        R.kk[t][0] = LDG8(BS.oK + ko_ + kl0); R.kk[t][1] = LDG8(BS.oK + ko_ + kl1); R.vv[t][0] = LDG8(BS.oV + ko_ + kl0); R.vv[t][1] = LDG8(BS.oV + ko_ + kl1); }
}
__device__ __forceinline__ void load_kv_commit(char* lds, const int tid, const KVRegs& R) {
    const int sr = tid >> 4, sc = (tid & 15) * 8, vst0 = v_st(sr, sc), vst1 = v_st(32 + sr, sc), kws = KSWZ(sr, sc * 2);
#pragma unroll
    for (int t = 0; t < 4; ++t) { *(bf16x8*)(lds + t * SHM_K + kws) = R.kk[t][0]; *(bf16x8*)(lds + t * SHM_K + kws + KROW32) = R.kk[t][1];
        *(bf16x8*)(lds + R_V + t * SHM_V + vst0) = R.vv[t][0]; *(bf16x8*)(lds + R_V + t * SHM_V + vst1) = R.vv[t][1]; }
}
__device__ __forceinline__ void load_kv(const Bases& BS, unsigned koff, int key0, char* lds, const int tid) { KVRegs R; load_kv_issue(BS, koff, key0, tid, R); load_kv_commit(lds, tid, R); }
template <int MODE> __device__ __forceinline__ void q_loads2(const Bases& BS, const CRef& u, QState& S, int wid, int r32, int hi) {
    unsigned ql;
    if constexpr (MODE == 1) { int row = wid * QBLK + r32; row = row < u.rows ? row : u.rows - 1; S.ent = *(const unsigned short*)(BS.wsb + (BS.oALIST + (u.lbase + (unsigned)row) * 2u)); ql = (unsigned)((S.ent & 4095u) * LD + hi * 8) * 2u; }
    else ql = (unsigned)((wid * QBLK + r32) * LD + hi * 8) * 2u;
    const unsigned qb_ = BS.oQ + u.qoff * 2u + ql;
#pragma unroll
    for (int d0 = 0; d0 < 8; ++d0) S.qr[d0] = LDG8(qb_ + d0 * 32);
}
template <int MODE>
__device__ __forceinline__ void chunk(const Bases& BS, const CRef& cur, const CRef& nxt, const bool has_next, char* lds, QState& S, const int tid, float& mo, float& lo, f32x16 (&o)[4]) {
    const int wid = __builtin_amdgcn_readfirstlane(tid >> 6), lane = tid & 63, r32 = lane & 31, hi = lane >> 5;
    char* K_lds = lds;
    float* ws = (float*)(lds + R_WS) + wid * 256; float* li_l = ws, * al_l = ws + 32; unsigned* entl = (unsigned*)(ws + 64);
    const int vb0 = (int)(uintptr_t)(lds + R_V) + v_rd_base(lane);
    const int wrow = (MODE == 0) ? rb0(wid) : wid;
    const int qlo = cur.qpos0 + wrow * QBLK, qm = qlo + r32 - 4 * hi;
    const bool active = (MODE == 0) || (wid * QBLK < cur.rows);
    float m_reg = -1e30f, l_reg = 0;
#pragma unroll
    for (int d = 0; d < 4; ++d) o[d] = f32x16{};
    if constexpr (MODE == 1) { if (hi == 0) entl[r32] = S.ent; }
    if (active) {
        f32x16 p0, p1; float mn, al; bf16x8 pa0, pa1, pa2, pa3;
#define TILE(t) do { if (MODE == 0 && (t) * KVBLK > wrow * QBLK + QBLK - 1) break; qkt<t>(p0, p1, K_lds, r32, hi, S.qr);                                                                 \
            if constexpr (MODE == 0) { const int kb_ = cur.qpos0 + (t) * KVBLK; if (kb_ + KVBLK - 1 > qlo) mask_causal(p0, p1, qm - kb_); }   \
            if ((t) == 3 && has_next) { SBAR(); q_loads2<MODE>(BS, nxt, S, wid, r32, hi); SBAR(); }                          \
            partialSM(p0, p1, m_reg, mn, al); finishSM(p0, p1, al, l_reg, pa0, pa1, pa2, pa3);                                \
            if (__any(al < 1.f)) { if (hi == 0) al_l[r32] = al; asm volatile("s_waitcnt lgkmcnt(0)" ::: "memory");            \
                for (int d_ = 0; d_ < 4; ++d_) for (int r = 0; r < 16; ++r) o[d_][r] *= al_l[crow(r, hi)]; }                  \
            SBAR(); pv_tile<t>(o, vb0, pa0, pa1, pa2, pa3); } while (0)
        TILE(0); TILE(1); TILE(2); TILE(3);
#undef TILE
    } else if (has_next) { q_loads2<MODE>(BS, nxt, S, wid, r32, hi); }
    mo = m_reg; lo = l_reg;
    if constexpr (MODE == 1) {
        if (active) {
            if (hi == 0) li_l[r32] = l_reg; asm volatile("s_waitcnt lgkmcnt(0)" ::: "memory");
            if (hi == 0 && wid * QBLK + r32 < cur.rows) { const unsigned e = entl[r32]; *(f32x2*)(BS.wsb + (BS.oPML + (((cur.pbase + (e & 4095u)) * 3u + (e >> 12) - 1u) << 3))) = (f32x2){m_reg, l_reg}; }
#pragma unroll
            for (int r = 0; r < 16; ++r) { const int row = crow(r, hi); const float rl = 16.f * __builtin_amdgcn_rcpf(li_l[row]); const unsigned e = entl[row];
                const unsigned pb_ = BS.oPART + ((((cur.pbase + (e & 4095u)) * 3u + (e >> 12) - 1u) << 7) + (unsigned)r32 * 4u);
                const unsigned pk = (unsigned)__builtin_amdgcn_cvt_pk_fp8_f32(o[2][r] * rl, o[3][r] * rl, __builtin_amdgcn_cvt_pk_fp8_f32(o[0][r] * rl, o[1][r] * rl, 0, false), true);
                if (wid * QBLK + row < cur.rows) *(unsigned*)(BS.wsb + pb_) = pk; }
        }
    }
}
__device__ __forceinline__ void own_finish(const Bases& BS, const CRef& cur, char* lds, const int tid, const float m_reg, const float l_reg, const f32x16 (&o)[4],
                                           const CRef& nxt, const unsigned nkoff, const int nkey0, QState& S, KVRegs& R) {
    const int wid = __builtin_amdgcn_readfirstlane(tid >> 6), lane = tid & 63, r32 = lane & 31, hi = lane >> 5;
    float* ws = (float*)(lds + R_WS) + wid * 256; float* li_l = ws; float* wts = ws + 96;
    char* ost = lds + wid * 8192;
    constexpr float C2 = 1.4426950408889634f * SCALE;
    const int ns = cur.ns;
    const int wrow = rb0(wid);
    f32x2 pm[3];
    const unsigned prow = (cur.pbase + (unsigned)(cur.qpos0 + wrow * QBLK + r32)) * 3u;
#pragma unroll
    for (int s2 = 0; s2 < 3; ++s2) pm[s2] = (s2 < ns) ? *(const f32x2*)(BS.wsb + (BS.oPML + ((prow + (unsigned)s2) << 3))) : (f32x2){-1e30f, 0.f};
    unsigned pp[16][3];
#pragma unroll
    for (int r = 0; r < 16; ++r) { const unsigned pro_ = BS.oPART + (((cur.pbase + (unsigned)(cur.qpos0 + wrow * QBLK + crow(r, hi))) * 3u) << 7) + (unsigned)r32 * 4u;
#pragma unroll
        for (int s2 = 0; s2 < 3; ++s2) pp[r][s2] = (s2 < ns) ? *(const unsigned*)(BS.wsb + (pro_ + (unsigned)s2 * 128u)) : 0u; }
    if (hi == 0) li_l[r32] = l_reg;
    if (hi == 0) { const float M = fmaxf(fmaxf(m_reg, pm[0][0]), fmaxf(pm[1][0], pm[2][0]));
        const float w0 = l_reg * __builtin_amdgcn_exp2f((m_reg - M) * C2), w1 = pm[0][1] * __builtin_amdgcn_exp2f((pm[0][0] - M) * C2), w2 = pm[1][1] * __builtin_amdgcn_exp2f((pm[1][0] - M) * C2), w3 = pm[2][1] * __builtin_amdgcn_exp2f((pm[2][0] - M) * C2);
        const float inv = __builtin_amdgcn_rcpf(w0 + w1 + w2 + w3);
        const float inv16 = inv * 0.0625f;
        *(f32x4*)(wts + r32 * 4) = (f32x4){w0 * inv, w1 * inv16, w2 * inv16, w3 * inv16}; }
    asm volatile("s_waitcnt lgkmcnt(0)" ::: "memory");
#pragma unroll
    for (int r = 0; r < 16; ++r) { const int orow = crow(r, hi); const f32x4 wv = *(const f32x4*)(wts + orow * 4); const float w0 = wv[0] * __builtin_amdgcn_rcpf(li_l[orow]);
        float mg[4] = {o[0][r] * w0, o[1][r] * w0, o[2][r] * w0, o[3][r] * w0};
#pragma unroll
        for (int s2 = 0; s2 < 3; ++s2) { const f32x2 p01 = __builtin_amdgcn_cvt_pk_f32_fp8((int)pp[r][s2], false), p23 = __builtin_amdgcn_cvt_pk_f32_fp8((int)pp[r][s2], true); const float wk = wv[s2 + 1];
            mg[0] += p01[0] * wk; mg[1] += p01[1] * wk; mg[2] += p23[0] * wk; mg[3] += p23[1] * wk; }
#pragma unroll
        for (int d0 = 0; d0 < 4; ++d0) { const float v = mg[d0];
            const float vn = __uint_as_float((unsigned)__builtin_amdgcn_update_dpp(0, (int)__float_as_uint(v), 0xB1, 0xF, 0xF, false));
            const unsigned pk = cvt_pk_bf16(v, vn);
            if ((r32 & 1) == 0) *(unsigned*)(ost + (orow * 128 + d0 * 32 + r32) * 2) = pk; } }
    load_kv_issue(BS, nkoff, nkey0, tid, R);
    q_loads2<0>(BS, nxt, S, wrow, r32, hi);
    asm volatile("s_waitcnt lgkmcnt(0)" ::: "memory");
    const unsigned ow_ = BS.oO + cur.qoff + (unsigned)(wrow * QBLK) * LD;
#pragma unroll
    for (int ii = 0; ii < 8; ++ii) { const int row = ii * 4 + (lane >> 4), ch = lane & 15; const u32x4 own = *(const u32x4*)(ost + (row * 128 + ch * 8) * 2);
        u32x2 w8; w8.x = __builtin_amdgcn_cvt_pk_fp8_f32(bf_lo(own.y), bf_hi(own.y), __builtin_amdgcn_cvt_pk_fp8_f32(bf_lo(own.x), bf_hi(own.x), 0u, false), true);
        w8.y = __builtin_amdgcn_cvt_pk_fp8_f32(bf_lo(own.w), bf_hi(own.w), __builtin_amdgcn_cvt_pk_fp8_f32(bf_lo(own.z), bf_hi(own.z), 0u, false), true);
        *(u32x2*)(BS.wsb + (ow_ + (unsigned)row * LD + (unsigned)ch * 8u)) = w8; }
}
#undef LDG8
#undef VMW
#undef VMWN
#undef SLOAD_H
#undef SWRITE_HK
#undef SWRITE_HV
#undef SWRITE_H
#undef SBAR
#undef KSWZ
}

constexpr int NWAVES = 8;
constexpr int N_LAUNCHES = MK_N_LAUNCHES;
constexpr int PER_PHASE = 13;
constexpr size_t MiB = 1u << 20;
constexpr size_t WS_CTL = 0, CTL_ZERO_BYTES = 1 * MiB;
constexpr size_t WS_SGUW = 1 * MiB;
constexpr size_t WS_ROPE = WS_SGUW + 256 * 1024;
constexpr size_t WS_KM = 2 * MiB;
constexpr size_t WS_TOKW = WS_KM + 256 * 1024;
constexpr size_t WS_WR = 3 * MiB;
constexpr size_t WS_LIST = 4 * MiB;
constexpr size_t WS_LISTR = 12 * MiB;
constexpr size_t WS_WIN = 8 * MiB;
constexpr size_t WS_WPA = 44 * MiB, WS_WPB = 48 * MiB, WS_WOUT = 52 * MiB;
constexpr size_t WS_H = 60 * MiB;
constexpr size_t WS_AO = 60 * MiB, WS_GO = 124 * MiB;
constexpr size_t WS_Q = 188 * MiB, WS_K = 252 * MiB, WS_V = 316 * MiB, WS_U = 380 * MiB, WS_VG = 444 * MiB;
constexpr size_t WS_GA = 508 * MiB, WS_GS = 636 * MiB;
constexpr size_t WS_MG = 764 * MiB;
constexpr size_t WS_LOG = 956 * MiB;
constexpr size_t WS_WGU = 976 * MiB;
constexpr size_t WS_WD = 892 * MiB;
constexpr size_t WS_H8 = 380 * MiB;
constexpr size_t WS_HID = 444 * MiB;
constexpr size_t WS_Y = 716 * MiB;
constexpr size_t WS_H1_8 = 892 * MiB;
constexpr size_t WS_WIN8 = 956 * MiB;
constexpr size_t WS_WPA8 = 974 * MiB;
constexpr size_t WS_ALIST = 764 * MiB;
constexpr size_t WS_PML = 772 * MiB;
constexpr size_t WS_PART = 780 * MiB;
constexpr size_t WS_END = 1104 * MiB;
constexpr int CW_TMO = 0, CW_CODE = 1;
constexpr int CW_CNT = 64;
constexpr int CW_WORK = 3072;
constexpr int CW_DONE = 3200;
constexpr int CW_BAR = 4096;
constexpr int CW_ACNT = 49152;
constexpr int CW_SS = 16384;
constexpr int RING_OFF = 0, RING_BYTES = 131072;
constexpr int SCR_BYTES = 8 * 17408;
constexpr int LDSCTL_OFF = 140288, MISC_OFF = LDSCTL_OFF + 320;
static_assert(SCR_BYTES <= LDSCTL_OFF && RING_BYTES + 9 * 256 * 4 <= LDSCTL_OFF, "LDS map");
constexpr int TAB_OFF = LDSCTL_OFF + 1024;
constexpr int TABA_OFF = 145408;
constexpr int LDS_BYTES = 151552;
static_assert(TABA_OFF + 1025 * 4 <= LDS_BYTES && TAB_OFF + (961 + 32) * 4 <= TABA_OFF && att::LDS_BYTES2 <= LDSCTL_OFF && att::R_BYTES <= LDSCTL_OFF, "LDS map");
static_assert(TAB_OFF + 961 * 4 <= LDS_BYTES, "LDS map");

typedef GAS unsigned gu32;
#define RLX_AGENT __ATOMIC_RELAXED, __HIP_MEMORY_SCOPE_AGENT
#define LDS_WAIT() asm volatile("s_waitcnt lgkmcnt(0)" ::: "memory")
#define VM_WAIT() asm volatile("s_waitcnt vmcnt(0)" ::: "memory")

#define XB_TMO      128
#define XB_XCNT(j)  (256  + 64 * (j))
#define XB_XSUB(j)  (1280 + 64 * (j))
#define XB_XGEN(j)  (2304 + 64 * (j))
#define XB_TOP      3328
#define XB_TOPGEN   3392
#define XCD_BAR_WORDS 3456
#define XB_SPIN_CAP (1u << 18)
__device__ __forceinline__ unsigned xb_ld(unsigned* p)              { return __hip_atomic_load(p, __ATOMIC_RELAXED, __HIP_MEMORY_SCOPE_AGENT); }
__device__ __forceinline__ unsigned xb_add(unsigned* p, unsigned v) { return __hip_atomic_fetch_add(p, v, __ATOMIC_RELAXED, __HIP_MEMORY_SCOPE_AGENT); }
__device__ __forceinline__ unsigned xb_xcc_id() { return (unsigned)__builtin_amdgcn_s_getreg((3 << 11) | 20) & 0xFu; }
#define XB_SPIN(cond, bar) do { unsigned _sp = 0; while (cond) { __builtin_amdgcn_s_sleep(1); \
    if ((++_sp & 255u) == 0u) { if (xb_ld(&(bar)[XB_TMO])) break; if (_sp > XB_SPIN_CAP) { atomicAdd(&(bar)[XB_TMO], 1u); break; } } } } while (0)
struct XcdBarrier { unsigned* bar; unsigned x; volatile LAS unsigned* st; };
__device__ __forceinline__ XcdBarrier xcd_barrier_post(unsigned* bar, volatile LAS unsigned* st) {
    XcdBarrier b; b.bar = bar; b.x = xb_xcc_id(); b.st = st;
    if (threadIdx.x == 0) (void)xb_add(&bar[XB_XCNT(b.x)], 1u);
    return b;
}
__device__ __forceinline__ void xcd_barrier_complete(unsigned* bar, unsigned x, unsigned& nloc, unsigned& nx, const unsigned G) {
    unsigned sum, cnt, mine, sp = 0u;
    for (;;) {
        sum = 0u; cnt = 0u; mine = 0u;
#pragma unroll
        for (unsigned j = 0; j < 16; ++j) { const unsigned c = xb_ld(&bar[XB_XCNT(j)]); sum += c; cnt += (c > 0u) ? 1u : 0u; mine = (j == x) ? c : mine; }
        if (sum == G) break;
        __builtin_amdgcn_s_sleep(1);
        if ((++sp & 255u) == 0u) { if (xb_ld(&bar[XB_TMO])) break; if (sp > XB_SPIN_CAP) { atomicAdd(&bar[XB_TMO], 1u); break; } }
    }
    nloc = mine > 0u ? mine : 1u; nx = cnt > 0u ? cnt : 1u;
}
__device__ __forceinline__ void xcd_barrier(const XcdBarrier& b) {
    asm volatile("s_waitcnt vmcnt(0)" ::: "memory");
    __syncthreads();
    if (threadIdx.x == 0) {
        unsigned* bar = b.bar;
        __builtin_amdgcn_s_waitcnt(0);
        unsigned nloc = b.st[0], nx = b.st[1];
        if (nloc == 0u) { xcd_barrier_complete(bar, b.x, nloc, nx, b.st[8]); b.st[0] = nloc; b.st[1] = nx; }
        const unsigned old = xb_add(&bar[XB_XSUB(b.x)], 1u);
        const unsigned gen = old / nloc;
        if (old + 1u == (gen + 1u) * nloc) {
            __builtin_amdgcn_fence(__ATOMIC_RELEASE, "agent");
            asm volatile("s_waitcnt vmcnt(0)" ::: "memory");
            const unsigned og = xb_add(&bar[XB_TOP], 1u);
            const unsigned tg = og / nx;
            if (og + 1u == (tg + 1u) * nx) xb_add(&bar[XB_TOPGEN], 1u);
            else XB_SPIN(xb_ld(&bar[XB_TOPGEN]) == tg, bar);
            __builtin_amdgcn_fence(__ATOMIC_ACQUIRE, "agent");
            xb_add(&bar[XB_XGEN(b.x)], 1u);
            asm volatile("s_waitcnt vmcnt(0)" ::: "memory");
        } else {
            XB_SPIN(xb_ld(&bar[XB_XGEN(b.x)]) == gen, bar);
            __builtin_amdgcn_fence(__ATOMIC_ACQUIRE, "agent");
            asm volatile("s_waitcnt vmcnt(0)" ::: "memory");
        }
    }
    __syncthreads();
}

struct Frame {
    LAS unsigned char* lds;
    volatile LAS unsigned* MISC;
    unsigned* ctl;
    int tid, lane, wave;
    int vcu, G;
    unsigned char* ws;
    float* out;
};

__device__ __forceinline__ float wave_sum(float v) {
#pragma unroll
    for (int o = 1; o < 64; o <<= 1) v += __shfl_xor(v, o);
    return v;
}
__device__ __forceinline__ unsigned f2bf(float f) { unsigned u = __builtin_bit_cast(unsigned, f); return (u + 0x7fffu + ((u >> 16) & 1u)) >> 16; }
__device__ __forceinline__ unsigned pk2(float lo, float hi) { return f2bf(lo) | (f2bf(hi) << 16); }

__device__ __forceinline__ void transpose_item(const float* W, int K, int N, bf16_t* WT, int k0, int n0, int drow0, LAS float* scr, int lane) {
    f32x4 v[8]; const float* src = W + (size_t)(k0 + (lane >> 3)) * N + n0 + 4 * (lane & 7);
#pragma unroll
    for (int i = 0; i < 8; ++i) v[i] = __builtin_nontemporal_load((const f32x4*)(src + (size_t)(8 * i) * N));
#pragma unroll
    for (int i = 0; i < 8; ++i) { LAS float* d = scr + ((lane >> 3) + 8 * i) * 33 + 4 * (lane & 7); d[0] = v[i][0]; d[1] = v[i][1]; d[2] = v[i][2]; d[3] = v[i][3]; }
    LDS_WAIT(); asm volatile("" ::: "memory");
    const int c = lane & 7;
#pragma unroll
    for (int j = 0; j < 4; ++j) { const int n = (lane >> 3) + 8 * j; const LAS float* s = scr + (8 * c) * 33 + n;
        u32x4 o; o.x = pk2(s[0 * 33], s[1 * 33]); o.y = pk2(s[2 * 33], s[3 * 33]); o.z = pk2(s[4 * 33], s[5 * 33]); o.w = pk2(s[6 * 33], s[7 * 33]);
        *(u32x4*)(WT + (size_t)(drow0 + n) * K + k0 + 8 * c) = o; }
    LDS_WAIT(); asm volatile("" ::: "memory");
}
__device__ __forceinline__ unsigned pk4_fp8(float a, float b, float c, float d) { unsigned w = __builtin_amdgcn_cvt_pk_fp8_f32(a, b, 0u, false); return __builtin_amdgcn_cvt_pk_fp8_f32(c, d, w, true); }
__device__ __forceinline__ void t8_issue(const float* W, int N, int k0, int n0, int lane, f32x4 (&v)[16]) {
    const float* src = W + (size_t)(k0 + 16 * (lane >> 3)) * N + n0 + 4 * (lane & 7);
#pragma unroll
    for (int i = 0; i < 16; ++i) v[i] = __builtin_nontemporal_load((const f32x4*)(src + (size_t)i * N));
}
__device__ __forceinline__ void t8_store(const f32x4 (&v)[16], unsigned char* WT, int K, int k0, int drow0, int lane, float scale) {
    unsigned char* dst = WT + (size_t)(drow0 + 4 * (lane & 7)) * K + k0 + 16 * (lane >> 3);
#pragma unroll
    for (int j = 0; j < 4; ++j) { u32x4 o;
        o.x = pk4_fp8(v[0][j] * scale, v[1][j] * scale, v[2][j] * scale, v[3][j] * scale); o.y = pk4_fp8(v[4][j] * scale, v[5][j] * scale, v[6][j] * scale, v[7][j] * scale);
        o.z = pk4_fp8(v[8][j] * scale, v[9][j] * scale, v[10][j] * scale, v[11][j] * scale); o.w = pk4_fp8(v[12][j] * scale, v[13][j] * scale, v[14][j] * scale, v[15][j] * scale);
        *(u32x4*)(dst + (size_t)j * K) = o; }
}
__device__ __forceinline__ void transpose_item8(const float* W, int K, int N, unsigned char* WT, int k0, int n0, int drow0, LAS float* scr, int lane, float scale) {
    (void)scr; f32x4 v[16]; t8_issue(W, N, k0, n0, lane, v); t8_store(v, WT, K, k0, drow0, lane, scale);
}
__device__ __forceinline__ int claim_async(unsigned* ctr, unsigned n) { int ret; asm volatile("global_atomic_add %0, %1, %2, off sc0" : "=v"(ret) : "v"(ctr), "v"(n) : "memory"); return ret; }
struct ConvItem { const float* W; unsigned char* WT; int K, N, k0, n0, drow0; };
__device__ __forceinline__ ConvItem conv_decode(int it, __attribute__((address_space(4))) const char* kp, unsigned char* ws) {
    constexpr int IGU = NE * 2 * (DM / 128) * (FF / 32);
    ConvItem c; int sel; size_t so, dof;
    if (it < IGU) { const int e = it >> 10, r = it & 1023, which = r >> 9, q = r & 511, kb = q >> 5, nb = q & 31, n0 = 32 * nb;
        sel = which; so = (size_t)e * DM * FF; c.K = DM; c.N = FF; dof = WS_WGU + (size_t)e * DM * DM; c.k0 = 128 * kb; c.n0 = n0; c.drow0 = (n0 >> 7) * 256 + which * 128 + (n0 & 127); }
    else { const int j = it - IGU, e = j >> 9, q = j & 511, kb = q >> 6, nb = q & 63;
        sel = 2; so = (size_t)e * FF * DM; c.K = FF; c.N = DM; dof = WS_WD + (size_t)e * DM * FF; c.k0 = 128 * kb; c.n0 = 32 * nb; c.drow0 = 32 * nb; }
    const float* wsrc = (const float*)(GAS const float*)(*(const __attribute__((address_space(4))) unsigned long long*)(kp + 8 * (15 + sel)));
    c.W = wsrc + so; c.WT = ws + dof;
    return c;
}
__device__ __forceinline__ void conv_issue(const ConvItem& c, int lane, f32x4 (&v)[16]) { t8_issue(c.W, c.N, c.k0, c.n0, lane, v); }
__device__ __forceinline__ void conv_process(const ConvItem& cc, const f32x4 (&v)[16], LAS float* scr, int lane, float scale) { (void)scr; t8_store(v, cc.WT, cc.K, cc.k0, cc.drow0, lane, scale); }
__device__ __forceinline__ void transpose_matrix(Frame& F, const float* W, int K, int N, bf16_t* WT, LAS float* scr) {
    const int gw = F.vcu * NWAVES + F.wave, NGW = F.G * NWAVES; const int nblk = N / 32, items = (K / 64) * nblk;
    for (int it = gw; it < items; it += NGW) { const int kb = it / nblk, nb = it % nblk; transpose_item(W, K, N, WT, 64 * kb, 32 * nb, 32 * nb, scr, F.lane); }
}
__device__ __forceinline__ void rms_row_to_bf16(Frame& F, const float* xrow, const float* gain, bf16_t* orow, unsigned* orow8 = nullptr) {
    const f32x4* xr = (const f32x4*)xrow + F.lane; const f32x4* gr = (const f32x4*)gain + F.lane;
    f32x4 v[8]; float s = 0.f;
#pragma unroll
    for (int j = 0; j < 8; ++j) { v[j] = __builtin_nontemporal_load(xr + 64 * j); s += (v[j].x * v[j].x + v[j].y * v[j].y) + (v[j].z * v[j].z + v[j].w * v[j].w); }
    const float rstd = 1.0f / sqrtf(wave_sum(s) * (1.f / DM) + EPS);
    u32x2* o8 = (u32x2*)orow + F.lane;
#pragma unroll
    for (int j = 0; j < 8; ++j) { const f32x4 g = gr[64 * j]; const float y0 = v[j].x * rstd * g.x, y1 = v[j].y * rstd * g.y, y2 = v[j].z * rstd * g.z, y3 = v[j].w * rstd * g.w;
        u32x2 w; w.x = pk2(y0, y1); w.y = pk2(y2, y3); o8[64 * j] = w; if (orow8) orow8[64 * j + F.lane] = pk4_fp8(y0, y1, y2, y3); }
}

struct EpiProj {
    static constexpr bool PERM = true;
    unsigned char* ws; const f32x4* rope; int pn_base;
    __device__ __forceinline__ void operator()(const f32x4 (&acc)[2][2][4][2], const pg8::Unit& u, int wr, int wc, int fr, int fq) const {
#ifdef PROBE_SKIP_EPI
        if (u.x2) return;
#endif
        const int pn = u.pn + pn_base; int mode, ldc, colt; size_t boff;
        if (pn < 20) { const int t = pn >> 2; ldc = 1024; colt = (pn & 3) * 256; boff = WS_Q + (size_t)t * (64 * MiB); mode = (t < 2) ? 1 : (t == 2 ? 0 : 2); }
        else { const int t = (pn - 20) >> 3; ldc = 2048; colt = ((pn - 20) & 7) * 256; boff = WS_GA + (size_t)t * (128 * MiB); mode = 3; }
        bf16_t* base = (bf16_t*)(ws + boff);
        const int row0 = u.pm * 256 + wr * 64 + fr, col0 = colt + wc * 32 + 8 * fq;
        const bool do_rope = (mode == 1) && (wc == 0);
#pragma unroll
        for (int ai = 0; ai < 2; ++ai) {
            f32x4 cs[4][4];
#pragma unroll
            for (int m = 0; m < 4; ++m) { const int row = row0 + ai * 128 + m * 16; const f32x4* rp = rope + (do_rope ? ((size_t)(row & (SEQ - 1)) * 16 + 8 * (fq & 1)) / 2 : (size_t)0);
#pragma unroll
                for (int q = 0; q < 4; ++q) cs[m][q] = rp[q]; }
#pragma unroll
            for (int m = 0; m < 4; ++m) { const int row = row0 + ai * 128 + m * 16; bf16_t* rowp = base + (size_t)row * ldc + col0;
#pragma unroll
                for (int bj = 0; bj < 2; ++bj) { f32x4 v0 = acc[ai][bj][m][0], v1 = acc[ai][bj][m][1];
                    if (do_rope) {
                        float x[8] = {v0[0], v0[1], v0[2], v0[3], v1[0], v1[1], v1[2], v1[3]};
#pragma unroll
                        for (int e = 0; e < 8; ++e) { const auto sw_ = __builtin_amdgcn_permlane32_swap(__float_as_uint(x[e]), __float_as_uint(x[e]), false, false);
                            const float p = __uint_as_float(fq < 2 ? sw_[1] : sw_[0]); const float c = cs[m][e >> 1][(e & 1) * 2], sn = cs[m][e >> 1][(e & 1) * 2 + 1];
                            x[e] = (fq < 2) ? (x[e] * c - p * sn) : (x[e] * c + p * sn); }
                        v0 = (f32x4){x[0], x[1], x[2], x[3]}; v1 = (f32x4){x[4], x[5], x[6], x[7]};
                    } else if (mode == 2) {
#pragma unroll
                        for (int e = 0; e < 4; ++e) { v0[e] = gelu_tanh_f(v0[e]); v1[e] = gelu_tanh_f(v1[e]); }
                    } else if (mode == 3) {
#pragma unroll
                        for (int e = 0; e < 4; ++e) { v0[e] = sigmoid_f(v0[e]); v1[e] = sigmoid_f(v1[e]); }
                    }
                    u32x4 w; w.x = cvt_pk_bf16(v0[0], v0[1]); w.y = cvt_pk_bf16(v0[2], v0[3]); w.z = cvt_pk_bf16(v1[0], v1[1]); w.w = cvt_pk_bf16(v1[2], v1[3]);
                    __builtin_nontemporal_store(w, (u32x4*)(rowp + bj * 128)); } }
#pragma unroll
            for (int m = 0; m < 4; ++m) asm volatile("" :: "v"(cs[m][0]), "v"(cs[m][1]), "v"(cs[m][2]), "v"(cs[m][3]));
        }
    }
};
template <bool ADD> struct EpiGate {
    static constexpr bool PERM = true;
    const bf16_t* gate; bf16_t* out;
    __device__ __forceinline__ void operator()(const f32x4 (&acc)[2][2][4][2], const pg8::Unit& u, int wr, int wc, int fr, int fq) const {
        const int row0 = u.pm * 256 + wr * 64 + fr, col0 = u.pn * 256 + wc * 32 + 8 * fq;
#pragma unroll
        for (int ai = 0; ai < 2; ++ai) {
            u32x4 g[4][2], p[4][2];
#pragma unroll
            for (int m = 0; m < 4; ++m) { const size_t off = (size_t)(row0 + ai * 128 + m * 16) * DM + col0;
#pragma unroll
                for (int bj = 0; bj < 2; ++bj) { g[m][bj] = *(const u32x4*)(gate + off + bj * 128); if (ADD) p[m][bj] = *(const u32x4*)(out + off + bj * 128); } }
#pragma unroll
            for (int m = 0; m < 4; ++m) { const size_t off = (size_t)(row0 + ai * 128 + m * 16) * DM + col0;
#pragma unroll
                for (int bj = 0; bj < 2; ++bj) { const f32x4 v0 = acc[ai][bj][m][0], v1 = acc[ai][bj][m][1]; const u32x4 gg = g[m][bj];
                    float r[8] = {v0[0] * bf_lo(gg.x), v0[1] * bf_hi(gg.x), v0[2] * bf_lo(gg.y), v0[3] * bf_hi(gg.y), v1[0] * bf_lo(gg.z), v1[1] * bf_hi(gg.z), v1[2] * bf_lo(gg.w), v1[3] * bf_hi(gg.w)};
                    if (ADD) { const u32x4 pp = p[m][bj];
                        r[0] += bf_lo(pp.x); r[1] += bf_hi(pp.x); r[2] += bf_lo(pp.y); r[3] += bf_hi(pp.y); r[4] += bf_lo(pp.z); r[5] += bf_hi(pp.z); r[6] += bf_lo(pp.w); r[7] += bf_hi(pp.w); }
                    u32x4 w; w.x = cvt_pk_bf16(r[0], r[1]); w.y = cvt_pk_bf16(r[2], r[3]); w.z = cvt_pk_bf16(r[4], r[5]); w.w = cvt_pk_bf16(r[6], r[7]);
                    *(u32x4*)(out + off + bj * 128) = w; } }
        }
    }
};
struct EpiResNorm {
    static constexpr bool PERM = true;
    const float* x; const float* g; bf16_t* h2u; unsigned char* h2u8; float* ss;
    __device__ __forceinline__ void operator()(const f32x4 (&acc)[2][2][4][2], const pg8::Unit& u, int wr, int wc, int fr, int fq) const {
        const int row0 = u.pm * 256 + wr * 64 + fr, col0 = u.pn * 256 + wc * 32 + 8 * fq;
        f32x4 gv[2][2];
#pragma unroll
        for (int bj = 0; bj < 2; ++bj) { gv[bj][0] = *(const f32x4*)(g + col0 + bj * 128); gv[bj][1] = *(const f32x4*)(g + col0 + bj * 128 + 4); }
#pragma unroll
        for (int ai = 0; ai < 2; ++ai)
#pragma unroll
            for (int mp = 0; mp < 2; ++mp) {
                f32x4 xv[2][2][2];
#pragma unroll
                for (int mm = 0; mm < 2; ++mm) { const size_t off = (size_t)(row0 + ai * 128 + (mp * 2 + mm) * 16) * DM + col0;
#pragma unroll
                    for (int bj = 0; bj < 2; ++bj) { xv[mm][bj][0] = *(const f32x4*)(x + off + bj * 128); xv[mm][bj][1] = *(const f32x4*)(x + off + bj * 128 + 4); } }
#pragma unroll
                for (int mm = 0; mm < 2; ++mm) { const int m = mp * 2 + mm; const int row = row0 + ai * 128 + m * 16; const size_t off = (size_t)row * DM + col0; float sq = 0.f;
#pragma unroll
                    for (int bj = 0; bj < 2; ++bj) { const f32x4 v0 = xv[mm][bj][0] + acc[ai][bj][m][0], v1 = xv[mm][bj][1] + acc[ai][bj][m][1];
                        sq += (v0[0] * v0[0] + v0[1] * v0[1]) + (v0[2] * v0[2] + v0[3] * v0[3]) + (v1[0] * v1[0] + v1[1] * v1[1]) + (v1[2] * v1[2] + v1[3] * v1[3]);
                        const f32x4 h0 = v0 * gv[bj][0], h1 = v1 * gv[bj][1];
                        u32x4 w; w.x = cvt_pk_bf16(h0[0], h0[1]); w.y = cvt_pk_bf16(h0[2], h0[3]); w.z = cvt_pk_bf16(h1[0], h1[1]); w.w = cvt_pk_bf16(h1[2], h1[3]);
                        *(u32x4*)(h2u + off + bj * 128) = w;
                        u32x2 w8; w8.x = pk4_fp8(h0[0], h0[1], h0[2], h0[3]); w8.y = pk4_fp8(h1[0], h1[1], h1[2], h1[3]);
                        *(u32x2*)(h2u8 + off + bj * 128) = w8; }
                    sq += __shfl_xor(sq, 16); sq += __shfl_xor(sq, 32);
                    if (fq == 0 && !u.x2) (void)__hip_atomic_fetch_add(ss + row, sq, __ATOMIC_RELAXED, __HIP_MEMORY_SCOPE_AGENT); }
            }
    }
};
struct EpiLogits {
    static constexpr bool PERM = false;
    float* out;
    __device__ __forceinline__ void operator()(const f32x4 (&acc)[2][2][4][2], const pg8::Unit& u, int wr, int wc, int fr, int fq) const {
        if (wc >= 2) return;
        const int row0 = u.pm * 256 + wr * 64 + fr, col0 = wc * 32 + 4 * fq;
#pragma unroll
        for (int ai = 0; ai < 2; ++ai)
#pragma unroll
            for (int m = 0; m < 4; ++m) { float* rowp = out + (size_t)(row0 + ai * 128 + m * 16) * 64 + col0;
#pragma unroll
                for (int n = 0; n < 2; ++n) *(f32x4*)(rowp + n * 16) = acc[ai][0][m][n]; }
    }
};
struct EpiSwiglu {
    static constexpr bool PERM = true;
    unsigned char* hid; const float* listr;
    __device__ __forceinline__ void operator()(const f32x4 (&acc)[2][2][4][2], const pg8::Unit& u, int wr, int wc, int fr, int fq) const {
        const int row0 = u.pm * 256 + wr * 64 + fr, col0 = u.pn * 128 + wc * 32 + 8 * fq, r0 = wr * 64 + fr;
        float rs[2][4];
#pragma unroll
        for (int ai = 0; ai < 2; ++ai)
#pragma unroll
            for (int m = 0; m < 4; ++m) { const int r = r0 + ai * 128 + m * 16; rs[ai][m] = listr[u.x0 + (r < u.x1 ? r : 0)]; }
#pragma unroll
        for (int ai = 0; ai < 2; ++ai) {
#pragma unroll
            for (int m = 0; m < 4; ++m) { unsigned char* rowp = hid + (size_t)(row0 + ai * 128 + m * 16) * FF + col0;
                const float rstd = rs[ai][m];
                const f32x4 g0 = acc[ai][0][m][0] * rstd, g1 = acc[ai][0][m][1] * rstd, u0 = acc[ai][1][m][0] * rstd, u1 = acc[ai][1][m][1] * rstd;
                float r[8];
#pragma unroll
                for (int e = 0; e < 4; ++e) { r[e] = silu_f(g0[e]) * u0[e]; r[4 + e] = silu_f(g1[e]) * u1[e]; }
                u32x2 w; w.x = pk4_fp8(r[0], r[1], r[2], r[3]); w.y = pk4_fp8(r[4], r[5], r[6], r[7]);
                *(u32x2*)rowp = w; }
        }
    }
};
struct EpiScatter {
    static constexpr bool PERM = true;
    const int* list; unsigned char* Y;
    __device__ __forceinline__ void operator()(const f32x4 (&acc)[2][2][4][2], const pg8::Unit& u, int wr, int wc, int fr, int fq) const {
        const int r0 = wr * 64 + fr, col0 = u.pn * 256 + wc * 32 + 8 * fq;
        int aid[2][4];
#pragma unroll
        for (int ai = 0; ai < 2; ++ai)
#pragma unroll
            for (int m = 0; m < 4; ++m) { const int r = r0 + ai * 128 + m * 16; aid[ai][m] = list[u.x0 + (r < u.x1 ? r : 0)]; }
#pragma unroll
        for (int ai = 0; ai < 2; ++ai)
#pragma unroll
            for (int m = 0; m < 4; ++m) { const int r = r0 + ai * 128 + m * 16;
                if (r < u.x1) { unsigned char* rowp = Y + (size_t)aid[ai][m] * DM + col0;
#pragma unroll
                    for (int bj = 0; bj < 2; ++bj) { const f32x4 v0 = acc[ai][bj][m][0], v1 = acc[ai][bj][m][1];
                        u32x2 w; w.x = pk4_fp8(v0[0], v0[1], v0[2], v0[3]); w.y = pk4_fp8(v1[0], v1[1], v1[2], v1[3]);
                        *(u32x2*)(rowp + bj * 128) = w; } } }
        asm volatile("" :: "v"(aid[0][0]), "v"(aid[0][1]), "v"(aid[0][2]), "v"(aid[0][3]), "v"(aid[1][0]), "v"(aid[1][1]), "v"(aid[1][2]), "v"(aid[1][3]));
    }
};

template <bool GATHER_> struct MoeOrder {
    static constexpr bool GATHER = GATHER_;
    const LAS int* tab; int nrb, G, vcu; const char* A; const char* Bt; size_t a_rb_bytes, b_e_bytes, b_pn_bytes; const int* list;
    __device__ __forceinline__ bool next(int i, pg8::Unit& u) const {
        int Lv = i * G + vcu; const int slots = ((nrb + 3) >> 2) << 5; if (Lv >= slots * REP_MOE) return false; Lv %= slots;
        const int rb = (Lv >> 5) * 4 + ((Lv & 31) >> 3), pn = Lv & 7;
        const int rbc = rb < nrb ? rb : nrb - 1;
        const int e = __builtin_amdgcn_readfirstlane(tab[rbc]); u.pm = rbc; u.pn = pn; u.x0 = __builtin_amdgcn_readfirstlane(tab[320 + rbc]); u.x1 = __builtin_amdgcn_readfirstlane(tab[640 + rbc]); u.x2 = e;
        u.A = GATHER_ ? A : A + (size_t)rbc * a_rb_bytes; u.B = Bt + (size_t)e * b_e_bytes + (size_t)pn * b_pn_bytes; return true;
    }
    const LAS unsigned* rowtab;
    __device__ __forceinline__ unsigned row_off(const pg8::Unit&, int idx, int r) const { return rowtab[idx * 256 + r]; }
};

struct Args { const float* in[19]; float* out; unsigned char* ws; int ph_lo, ph_hi, li, pad; };
static_assert(offsetof(Args, out) == 152 && offsetof(Args, ws) == 160, "kernarg offsets used by KARG_PTR");

__global__ void __launch_bounds__(NWAVES * 64, 2) fwd_kernel(Args args) {
    extern __shared__ __attribute__((aligned(16))) unsigned char lds[];
    { const int t0_ = threadIdx.x; for (int u = t0_; u < (LDS_BYTES - LDSCTL_OFF) / 4; u += NWAVES * 64) ((LAS unsigned*)((LAS unsigned char*)lds + LDSCTL_OFF))[u] = 0u; }
    __syncthreads();
    if (threadIdx.x == 0) ((LAS unsigned*)((LAS unsigned char*)lds + MISC_OFF))[16] = gridDim.x;
    __syncthreads();
    unsigned* const ctl0 = (unsigned*)(args.ws + WS_CTL);
    XcdBarrier bar; bar.bar = ctl0 + CW_BAR; bar.x = 0; bar.st = nullptr;
    if (N_LAUNCHES != PER_PHASE) bar = xcd_barrier_post(ctl0 + CW_BAR + args.li * XCD_BAR_WORDS, (volatile LAS unsigned*)((LAS unsigned char*)lds + MISC_OFF) + 8);
#define GRID_BAR() do { if (N_LAUNCHES == PER_PHASE) { if (threadIdx.x == 0) __hip_atomic_store((unsigned*)(args.ws + WS_CTL) + CW_TMO, 0xBADBA0u, RLX_AGENT); } else { xcd_barrier(bar); } } while (0)
    const int lo = (N_LAUNCHES == 1) ? 0 : args.ph_lo, hi = (N_LAUNCHES == 1) ? PER_PHASE : args.ph_hi;
#ifndef PH_MASK
#define PH_MASK 0xFFFF
#endif
#define IN(k) ((((PH_MASK) >> (k)) & 1) && lo <= (k) && (k) < hi)
#define BOTH(k) (IN(k) && IN((k) + 1))
    typedef __attribute__((address_space(4))) const char* kptr_t;
#define KARG_PTR(T_, off_) ((T_*)(GAS T_*)(*(const __attribute__((address_space(4))) unsigned long long*)(kp_ + (off_))))
#define KARG_IN(k) KARG_PTR(const float, 8 * (k))
#define PH_CTX() \
    int tid_ = threadIdx.x; asm volatile("" : "+v"(tid_)); \
    int bx_ = blockIdx.x, G_ = __builtin_amdgcn_readfirstlane((int)((volatile LAS unsigned*)((LAS unsigned char*)lds + MISC_OFF))[16]); asm volatile("" : "+s"(bx_), "+s"(G_)); \
    kptr_t kp_ = (kptr_t)__builtin_amdgcn_kernarg_segment_ptr(); asm volatile("" : "+s"(kp_)); unsigned char* ws = KARG_PTR(unsigned char, 160); \
    Frame F; F.lds = (LAS unsigned char*)lds; F.MISC = (volatile LAS unsigned*)(F.lds + MISC_OFF); F.tid = tid_; F.lane = tid_ & 63; F.wave = __builtin_amdgcn_readfirstlane(tid_ >> 6); \
    F.G = G_; F.vcu = (G_ % 8 == 0) ? (bx_ % 8) * (G_ / 8) + bx_ / 8 : bx_; F.ws = ws; F.ctl = (unsigned*)(ws + WS_CTL); F.out = KARG_PTR(float, 152); \
    bf16_t* const H = (bf16_t*)(ws + WS_H); const int gw = F.vcu * NWAVES + F.wave, NGW = F.G * NWAVES; (void)H; (void)gw; (void)NGW

#define CONV_LOOP(POLL_, NA_, CH_) do { \
        int tc_ = threadIdx.x; asm volatile("" : "+v"(tc_)); const int lanec_ = tc_ & 63, wavec_ = __builtin_amdgcn_readfirstlane(tc_ >> 6); \
        LAS float* scr_ = nullptr;     \
        kptr_t kp_ = (kptr_t)__builtin_amdgcn_kernarg_segment_ptr(); asm volatile("" : "+s"(kp_)); unsigned char* ws = KARG_PTR(unsigned char, 160);     \
        constexpr int ITOT_ = NE * 2 * (DM / 128) * (FF / 32) + NE * (FF / 128) * (DM / 32);     \
        unsigned* poll_ = (POLL_); \
          \
          \
          \
        volatile LAS int* cl_ = (volatile LAS int*)(F.lds + MISC_OFF + 128); \
        int nb_ = 0, nd_ = 0; \
        if (tc_ == 0) { cl_[0] = (int)__hip_atomic_fetch_add(F.ctl + CW_WORK, 16u, __ATOMIC_RELAXED, __HIP_MEMORY_SCOPE_AGENT); cl_[2] = poll_ ? (int)__hip_atomic_load(poll_, RLX_AGENT) : 0; } \
        __syncthreads(); \
        for (int r_ = 0;; r_ ^= 1) { \
            const int base_ = __builtin_amdgcn_readfirstlane(cl_[r_]), dn_ = __builtin_amdgcn_readfirstlane(cl_[2 + r_]); \
            if (base_ >= ITOT_) break; \
            const bool stop_ = poll_ && dn_ >= (NA_); \
            if (!stop_ && tc_ == 0) { nb_ = claim_async(F.ctl + CW_WORK, 16u); if (poll_) nd_ = (int)__hip_atomic_load(poll_, RLX_AGENT); } \
            const int it_ = base_ + 2 * wavec_; \
            if (it_ < ITOT_) { f32x4 va_[16], vb_[16]; \
              const ConvItem ca_ = conv_decode(it_, kp_, ws); \
              t8_issue(ca_.W, ca_.N, ca_.k0, ca_.n0, lanec_, va_); t8_issue(ca_.W, ca_.N, ca_.k0, ca_.n0 + 32, lanec_, vb_); \
              t8_store(va_, ca_.WT, ca_.K, ca_.k0, ca_.drow0, lanec_, 32.0f); t8_store(vb_, ca_.WT, ca_.K, ca_.k0, ca_.drow0 + 32, lanec_, 32.0f); \
              asm volatile("" : "+v"(nb_) : "v"(va_[15]), "v"(vb_[15])); }     \
            else if (!stop_ && tc_ == 0) asm volatile("s_waitcnt vmcnt(0)" ::: "memory"); \
            if (stop_) break; \
            if (tc_ == 0) { cl_[r_ ^ 1] = nb_; cl_[2 + (r_ ^ 1)] = nd_; } \
            asm volatile("s_waitcnt lgkmcnt(0)" ::: "memory"); __builtin_amdgcn_s_barrier(); \
        } (void)scr_; } while (0)
#define ROLE_CTX() const bool split_ = (F.G == 320); const bool conv_ = split_ && (F.vcu % 5 == 4); const int na_ = split_ ? 256 : F.G, av_ = split_ ? F.vcu - F.vcu / 5 : F.vcu
#define ROLE_CTX38() const bool split_ = (F.G == 256); const bool conv_ = split_ && ((F.vcu & 7) >= 5); const int na_ = split_ ? 160 : F.G, av_ = split_ ? (F.vcu >> 3) * 5 + (F.vcu & 7) : F.vcu
#define ROLE_DONE(k_) do { __syncthreads(); if (threadIdx.x == 0) (void)__hip_atomic_fetch_add(F.ctl + CW_DONE + 64 * (k_), 1u, __ATOMIC_RELAXED, __HIP_MEMORY_SCOPE_AGENT); } while (0)

    if (IN(0)) {
        PH_CTX();
        for (int rep0_ = 0; rep0_ < REP_P0; ++rep0_) {
        LAS float* scr = (LAS float*)(F.lds + RING_OFF + F.wave * 17408);
        { const int nblk = 1024 / 32, items = (DM / 64) * nblk;
          for (int it = gw; it < items; it += NGW) { const int kb = it / nblk, nb = it % nblk; transpose_item(KARG_IN(2), DM, NPROJ, (bf16_t*)(ws + WS_WIN), 64 * kb, 3072 + 32 * nb, 32 * nb, scr, F.lane); } }
        { LAS float* scr8 = scr;
          constexpr int I1 = (DM / 128) * (NPROJ / 32), I2 = (DA / 128) * (DM / 32);
          for (int it = gw; it < I1 + I2; it += NGW) {
              if (it < I1) { const int kb = it / (NPROJ / 32), nb = it % (NPROJ / 32); transpose_item8(KARG_IN(2), DM, NPROJ, ws + WS_WIN8, 128 * kb, 32 * nb, 32 * nb, scr8, F.lane, 32.0f); }
              else { const int q = it - I1, kb = q / (DM / 32), nb = q % (DM / 32); transpose_item8(KARG_IN(7), DA, DM, ws + WS_WPA8, 128 * kb, 32 * nb, 32 * nb, scr8, F.lane, 32.0f); } } }
        transpose_matrix(F, KARG_IN(8), DS, DM, (bf16_t*)(ws + WS_WPB), scr);
        transpose_matrix(F, KARG_IN(9), DM, DM, (bf16_t*)(ws + WS_WOUT), scr);
        const int gt = F.vcu * (NWAVES * 64) + F.tid, NGT = F.G * NWAVES * 64;
        { bf16_t* WR = (bf16_t*)(ws + WS_WR); const float* wrg = KARG_IN(11); const float* wre = KARG_IN(13);
          for (int i = gt; i < 256 * DM; i += NGT) { const int j = i / DM, k = i % DM; float v = 0.f; if (j < 4) v = wrg[k * 4 + j]; else if (j < 36) v = wre[k * 32 + (j - 4)]; WR[i] = (bf16_t)f2bf(v); } }
        { bf16_t* SW = (bf16_t*)(ws + WS_SGUW); const float* sw = KARG_IN(3);
          for (int i = gt; i < SGU_G * 128 * 128; i += NGT) { const int t = (i >> 7) & 127, s = i & 127; SW[i] = (bf16_t)f2bf(s <= t ? sw[i] : 0.f); } }
        { float* RT = (float*)(ws + WS_ROPE);
          for (int i = gt; i < SEQ * 16; i += NGT) { const int pos = i >> 4, j = i & 15; const float inv = powf(500000.0f, -(float)j / 16.0f); const float ang = (float)pos * inv; RT[2 * i] = cosf(ang); RT[2 * i + 1] = sinf(ang); } }
        for (int m = gw; m < T; m += NGW) rms_row_to_bf16(F, KARG_IN(0) + (size_t)m * DM, KARG_IN(1), H + (size_t)m * DM, (unsigned*)(ws + WS_H1_8 + (size_t)m * DM));
        }
        if (BOTH(0)) GRID_BAR();
    }
    if (IN(1)) {
        PH_CTX();
        {
            pg8::DenseOrder S; S.init(ws + WS_H1_8, ws + WS_WIN8, T, 256 * 32, DM / 2, F.G, bx_, ((REP_GEMM >> 1) & 1) + 1, 12, 4);
            EpiProj E{ws, (const f32x4*)(ws + WS_ROPE), 0};
            pg8::gemm_phase<EpiProj, pg8::DenseOrder, true, true, true>(F.lds + RING_OFF, DM / 2, S, E, F.tid);
        }
        {
            pg8::DenseOrder S; S.init(H, ws + WS_WIN, T, 256 * 4, DM, F.G, bx_, ((REP_GEMM >> 1) & 1) + 1);
            EpiProj E{ws, (const f32x4*)(ws + WS_ROPE), 12};
            pg8::gemm_phase<EpiProj, pg8::DenseOrder, true, true>(F.lds + RING_OFF, DM, S, E, F.tid);
        }
        if (BOTH(1)) GRID_BAR();
    }
    if (IN(2)) {
        PH_CTX();
        const bf16_t* Kb = (const bf16_t*)(ws + WS_K); bf16_t* KM = (bf16_t*)(ws + WS_KM);
        LAS float* red = (LAS float*)(F.lds + RING_OFF);
        for (int it = F.vcu; it < BATCH * NBLK * NH; it += F.G) {
            const int h = it & 7, bb = it >> 3;
            const int cc = F.tid & 15, rg = F.tid >> 4;
            float s[8] = {0.f, 0.f, 0.f, 0.f, 0.f, 0.f, 0.f, 0.f};
            const bf16_t* src = Kb + ((size_t)bb * 256 + rg) * 1024 + h * 128 + cc * 8;
#pragma unroll
            for (int j = 0; j < 8; ++j) { const u32x4 v = *(const u32x4*)(src + (size_t)j * 32 * 1024);
                s[0] += bf_lo(v.x); s[1] += bf_hi(v.x); s[2] += bf_lo(v.y); s[3] += bf_hi(v.y); s[4] += bf_lo(v.z); s[5] += bf_hi(v.z); s[6] += bf_lo(v.w); s[7] += bf_hi(v.w); }
#pragma unroll
            for (int e = 0; e < 8; ++e) red[rg * 128 + cc * 8 + e] = s[e];
            __syncthreads();
            if (F.tid < 128) { float a = 0.f;
#pragma unroll 8
                for (int r = 0; r < 32; ++r) a += red[r * 128 + F.tid];
                KM[(size_t)bb * 1024 + h * 128 + F.tid] = (bf16_t)f2bf(a * (1.0f / 256.0f)); }
            __syncthreads();
        }
        if (BOTH(2)) GRID_BAR();
    }
    if (IN(3)) {
        PH_CTX();
        att::Bases BS; BS.wsb = ws; BS.oQ = (unsigned)WS_Q; BS.oK = (unsigned)WS_K; BS.oV = (unsigned)WS_V; BS.oO = (unsigned)WS_AO; BS.oPART = (unsigned)WS_PART; BS.oPML = (unsigned)WS_PML; BS.oALIST = (unsigned)WS_ALIST;
        unsigned* ACNT = F.ctl + CW_ACNT;
        {
            LAS unsigned* lcnt = (LAS unsigned*)(F.lds + RING_OFF);
            const bf16_t* KM = (const bf16_t*)(ws + WS_KM); unsigned short* AL = (unsigned short*)(ws + WS_ALIST);
            int tS = threadIdx.x; asm volatile("" : "+v"(tS)); const int laneS = tS & 63, r32 = laneS & 31, hi = laneS >> 5, waveS = __builtin_amdgcn_readfirstlane(tS >> 6);
            for (int it = F.vcu; it < BATCH * NH * 15; it += F.G) {
                const int bh = it / 15, bq = it % 15 + 1, b = bh >> 3, h = bh & 7;
                if (tS < 32) lcnt[tS] = 0u;
                __syncthreads();
                const bf16_t* qb = (const bf16_t*)(ws + WS_Q) + ((size_t)(b * SEQ + bq * 256) * 1024 + h * 128); const unsigned ql = (unsigned)((waveS * 32 + r32) * 1024 + hi * 8) * 2u;
                bf16x8 qr[8];
#pragma unroll
                for (int d0 = 0; d0 < 8; ++d0) qr[d0] = *(const bf16x8*)((const char*)qb + (ql + d0 * 32));
                unsigned m = att::moba_select(qr, KM + ((size_t)b * NBLK * 1024 + h * 128), bq, r32, hi);
                int j0 = -1, j1 = -1, j2 = -1; unsigned k0 = 0, k1 = 0, k2 = 0;
                if (hi == 0) {
                    if (m) { j0 = __builtin_ctz(m); m &= m - 1; k0 = __hip_atomic_fetch_add(lcnt + j0, 1u, __ATOMIC_RELAXED, __HIP_MEMORY_SCOPE_WORKGROUP); }
                    if (m) { j1 = __builtin_ctz(m); m &= m - 1; k1 = __hip_atomic_fetch_add(lcnt + j1, 1u, __ATOMIC_RELAXED, __HIP_MEMORY_SCOPE_WORKGROUP); }
                    if (m) { j2 = __builtin_ctz(m); k2 = __hip_atomic_fetch_add(lcnt + j2, 1u, __ATOMIC_RELAXED, __HIP_MEMORY_SCOPE_WORKGROUP); }
                }
                __syncthreads();
                if (tS < 16) { const unsigned cn = lcnt[tS]; lcnt[16 + tS] = cn ? atomicAdd(ACNT + bh * 16 + tS, cn) : 0u; }
                __syncthreads();
                if (hi == 0) { const unsigned qpos = (unsigned)(bq * 256 + waveS * 32 + r32);
                    if (j0 >= 0) AL[(size_t)(bh * 16 + j0) * att::LCAP + lcnt[16 + j0] + k0] = (unsigned short)(qpos | (1u << 12));
                    if (j1 >= 0) AL[(size_t)(bh * 16 + j1) * att::LCAP + lcnt[16 + j1] + k1] = (unsigned short)(qpos | (2u << 12));
                    if (j2 >= 0) AL[(size_t)(bh * 16 + j2) * att::LCAP + lcnt[16 + j2] + k2] = (unsigned short)(qpos | (3u << 12)); }
                __syncthreads();
            }
        }
        GRID_BAR();
        {
            ROLE_CTX38();
            if (conv_) { CONV_LOOP(F.ctl + CW_DONE, na_, 2); } else {
            LAS int* pre = (LAS int*)(F.lds + TABA_OFF);
            int tA = threadIdx.x; asm volatile("" : "+v"(tA)); const int laneA = tA & 63;
            if (tA < 64) { int c[16]; int sum = 0;
#pragma unroll
                for (int k = 0; k < 16; ++k) { const int cn = (int)__hip_atomic_load(ACNT + laneA * 16 + k, RLX_AGENT); c[k] = (cn + 255) >> 8; sum += c[k]; }
                int inc = sum;
#pragma unroll
                for (int o = 1; o < 64; o <<= 1) { const int t = __shfl_up(inc, o); if (laneA >= o) inc += t; }
                int ex = inc - sum;
#pragma unroll
                for (int k = 0; k < 16; ++k) { pre[laneA * 16 + k] = ex; ex += c[k]; }
                if (laneA == 63) pre[1024] = inc; }
            __syncthreads();
            int NU = __builtin_amdgcn_readfirstlane(pre[1024]); NU = NU < 0 ? 0 : (NU > 7680 ? 7680 : NU);
            const int ub = (int)(((long)av_ * NU * REP_A2) / na_), ue = (int)(((long)(av_ + 1) * NU * REP_A2) / na_);
            if (ub < ue) {
                int li, cc, cnt, nch;
                { int lo_ = 0, hi_ = 1024; const int u0 = ub % NU;
#pragma unroll
                  for (int s_ = 0; s_ < 10; ++s_) { const int mid_ = (lo_ + hi_) >> 1; if (pre[mid_] <= u0) lo_ = mid_; else hi_ = mid_; }
                  li = __builtin_amdgcn_readfirstlane(lo_); cc = u0 - __builtin_amdgcn_readfirstlane(pre[li]); cnt = (int)__builtin_amdgcn_readfirstlane(__hip_atomic_load(ACNT + li, RLX_AGENT)); nch = (cnt + 255) >> 8; }
#define MKC1(r) do { const int bh_ = li >> 4, b_ = bh_ >> 3, h_ = bh_ & 7; (r).qoff = (unsigned)(b_ * SEQ * 1024 + h_ * 128); (r).lbase = (unsigned)(li * att::LCAP + cc * 256); \
                    (r).rows = (cnt - cc * 256) < 256 ? ((cnt - cc * 256) < 1 ? 1 : (cnt - cc * 256)) : 256; (r).pbase = (unsigned)(bh_ * 4096); (r).qpos0 = 0; (r).ns = 0; } while (0)
#define ADV1() do { ++cc; if (cc >= nch) { cc = 0; do { li = (li + 1) & 1023; cnt = (int)__builtin_amdgcn_readfirstlane(__hip_atomic_load(ACNT + li, RLX_AGENT)); nch = (cnt + 255) >> 8; } while (nch == 0); } } while (0)
                att::QState S; att::CRef cur; MKC1(cur);
                { const int wid_ = __builtin_amdgcn_readfirstlane(tA >> 6); att::q_loads2<1>(BS, cur, S, wid_, laneA & 31, laneA >> 5); }
                int resident = -1;
                for (int u = ub; u < ue; ++u) {
                    if (li != resident) { __syncthreads(); att::load_kv(BS, cur.qoff, (li & 15) * 256, (char*)lds + RING_OFF, tA); __syncthreads(); resident = li; }
                    const bool has_next = (u + 1 < ue);
                    att::CRef nxt = cur; if (has_next) { ADV1(); MKC1(nxt); }
                    float mo, lo2; f32x16 oacc[4];
                    att::chunk<1>(BS, cur, nxt, has_next, (char*)lds + RING_OFF, S, tA, mo, lo2, oacc);
                    cur = nxt;
                }
                __syncthreads();
#undef MKC1
#undef ADV1
            }
            ROLE_DONE(0);
            }
        }
        GRID_BAR();
        {
            const int NU = BATCH * NH * 16 * REP_ATT;
            int tB = threadIdx.x; asm volatile("" : "+v"(tB)); const int laneB = tB & 63, widB = __builtin_amdgcn_readfirstlane(tB >> 6);
#define MKC0(r, ko, k0, u_) do { const int uu = (u_) % (BATCH * NH * 16), bh_ = uu >> 4, bq_ = uu & 15, b_ = bh_ >> 3, h_ = bh_ & 7; (ko) = (unsigned)(b_ * SEQ * 1024 + h_ * 128); (k0) = bq_ * 256; \
                (r).qoff = (ko) + (unsigned)(bq_ * 256 * 1024); (r).lbase = 0u; (r).rows = 256; (r).pbase = (unsigned)(bh_ * 4096); (r).qpos0 = bq_ * 256; (r).ns = bq_ < 3 ? bq_ : 3; } while (0)
            ROLE_CTX();
            if (conv_) { CONV_LOOP(F.ctl + CW_DONE + 64, na_, 2); } else {
            if (av_ < NU) {
                att::CRef cur; unsigned koff; int key0; MKC0(cur, koff, key0, av_);
                att::QState S; att::KVRegs R;
                att::q_loads2<0>(BS, cur, S, att::rb0(widB), laneB & 31, laneB >> 5);
                att::load_kv_issue(BS, koff, key0, tB, R);
                for (int u = av_; u < NU; u += na_) {
                    __syncthreads();
                    att::load_kv_commit((char*)lds + RING_OFF, tB, R);
                    __syncthreads();
                    float mo, lo2; f32x16 oacc[4];
                    att::chunk<0>(BS, cur, cur, false, (char*)lds + RING_OFF, S, tB, mo, lo2, oacc);
                    __syncthreads();
                    att::CRef nxt = cur; unsigned nkoff = koff; int nkey0 = key0;
                    if (u + na_ < NU) MKC0(nxt, nkoff, nkey0, u + na_);
                    att::own_finish(BS, cur, (char*)lds + RING_OFF, tB, mo, lo2, oacc, nxt, nkoff, nkey0, S, R);
                    cur = nxt; koff = nkoff; key0 = nkey0;
                }
            }
#undef MKC0
            ROLE_DONE(1);
            }
            __syncthreads();
        }
        __syncthreads();
        {
            const bf16_t* Ub = (const bf16_t*)(ws + WS_U); const bf16_t* VGb = (const bf16_t*)(ws + WS_VG); bf16_t* Gb = (bf16_t*)(ws + WS_GO);
            const bf16_t* SW = (const bf16_t*)(ws + WS_SGUW); const float* sgu_b = KARG_IN(4); const float* ln_g = KARG_IN(5); const float* ln_b = KARG_IN(6);
            constexpr int VTP = 136;
            LAS bf16_t* vT = (LAS bf16_t*)(F.lds + RING_OFF);
            LAS float* stat = (LAS float*)(F.lds + RING_OFF + 128 * VTP * 2);
            int tG = threadIdx.x; asm volatile("" : "+v"(tG)); const int laneG = tG & 63, waveG = __builtin_amdgcn_readfirstlane(tG >> 6), r32 = laneG & 31, hi = laneG >> 5;
            for (int n0 = F.vcu; n0 < (T / SGU_CHUNK) * REP_SGU; n0 += F.G) { const int n = n0 % (T / SGU_CHUNK);
                const size_t t0 = (size_t)n * SGU_CHUNK;
                { u32x4 sa[16], sb[16];
#pragma unroll
                for (int rr = 0; rr < 16; ++rr) { const u32x4* p = (const u32x4*)(VGb + (t0 + waveG * 16 + rr) * 1024) + laneG * 2; sa[rr] = p[0]; sb[rr] = p[1]; }
#pragma unroll
                for (int rr = 0; rr < 16; ++rr) { const int row = waveG * 16 + rr;
                    const u32x4 a = sa[rr], b = sb[rr]; float v[16] = {bf_lo(a.x), bf_hi(a.x), bf_lo(a.y), bf_hi(a.y), bf_lo(a.z), bf_hi(a.z), bf_lo(a.w), bf_hi(a.w), bf_lo(b.x), bf_hi(b.x), bf_lo(b.y), bf_hi(b.y), bf_lo(b.z), bf_hi(b.z), bf_lo(b.w), bf_hi(b.w)};
                    float s = 0.f;
#pragma unroll
                    for (int e = 0; e < 16; ++e) s += v[e];
                    const float mean = wave_sum(s) * (1.f / 1024.f); float q = 0.f;
#pragma unroll
                    for (int e = 0; e < 16; ++e) { const float d = v[e] - mean; q += d * d; }
                    const float rstd = 1.0f / sqrtf(wave_sum(q) * (1.f / 1024.f) + EPS);
                    if (laneG == 0) { stat[row * 2] = mean; stat[row * 2 + 1] = rstd; } } }
                __syncthreads();
                for (int g = 0; g < SGU_G; ++g) {
                    const int tt = waveG >> 1, ct0 = (waveG & 1) * 2;
                    u32x4 vv[4];
#pragma unroll
                    for (int i = 0; i < 4; ++i) { const int q = tG + 512 * i, s_ = q >> 4, cc = (q & 15) * 8; vv[i] = *(const u32x4*)(VGb + (t0 + s_) * 1024 + g * 128 + cc); }
                    const bf16_t* wrow = SW + ((size_t)g * 128 + tt * 32 + r32) * 128 + hi * 8;
                    bf16x8 af[8];
#pragma unroll
                    for (int ks = 0; ks < 8; ++ks) af[ks] = *(const bf16x8*)(wrow + ks * 16);
                    const size_t orow_ = (t0 + tt * 32 + r32) * 1024 + g * 128 + ct0 * 32 + hi * 4;
                    u32x2 uu0[4], uu1[4];
#pragma unroll
                    for (int q = 0; q < 4; ++q) { uu0[q] = *(const u32x2*)(Ub + orow_ + q * 8); uu1[q] = *(const u32x2*)(Ub + orow_ + 32 + q * 8); }
                    const float bias = sgu_b[g * 128 + tt * 32 + r32];
#pragma unroll
                    for (int i = 0; i < 4; ++i) { const int q = tG + 512 * i, s = q >> 4, cc = (q & 15) * 8;
                        const u32x4 v = vv[i];
                        const float mean = stat[s * 2], rstd = stat[s * 2 + 1];
                        const f32x4 g0 = *(const f32x4*)(ln_g + g * 128 + cc), g1 = *(const f32x4*)(ln_g + g * 128 + cc + 4), b0 = *(const f32x4*)(ln_b + g * 128 + cc), b1 = *(const f32x4*)(ln_b + g * 128 + cc + 4);
                        float y[8] = {bf_lo(v.x), bf_hi(v.x), bf_lo(v.y), bf_hi(v.y), bf_lo(v.z), bf_hi(v.z), bf_lo(v.w), bf_hi(v.w)};
#pragma unroll
                        for (int e = 0; e < 8; ++e) { const float gg = e < 4 ? g0[e & 3] : g1[e & 3], bb = e < 4 ? b0[e & 3] : b1[e & 3]; y[e] = (y[e] - mean) * rstd * gg + bb; vT[(cc + e) * VTP + s] = (bf16_t)f2bf(y[e]); } }
                    __syncthreads();
                    f32x16 acc0 = f32x16{}, acc1 = f32x16{};
#pragma unroll
                    for (int ks = 0; ks < 8; ++ks) if (ks < 2 * (tt + 1)) {
                        const bf16x8 b0 = *(const LAS bf16x8*)(vT + (ct0 * 32 + r32) * VTP + ks * 16 + hi * 8);
                        const bf16x8 b1 = *(const LAS bf16x8*)(vT + ((ct0 + 1) * 32 + r32) * VTP + ks * 16 + hi * 8);
                        acc0 = __builtin_amdgcn_mfma_f32_32x32x16_bf16(b0, af[ks], acc0, 0, 0, 0);
                        acc1 = __builtin_amdgcn_mfma_f32_32x32x16_bf16(b1, af[ks], acc1, 0, 0, 0);
                    }
#pragma unroll
                    for (int q = 0; q < 4; ++q) {
                        u32x2 w0, w1;
                        w0.x = cvt_pk_bf16(bf_lo(uu0[q].x) * (acc0[4 * q + 0] + bias), bf_hi(uu0[q].x) * (acc0[4 * q + 1] + bias)); w0.y = cvt_pk_bf16(bf_lo(uu0[q].y) * (acc0[4 * q + 2] + bias), bf_hi(uu0[q].y) * (acc0[4 * q + 3] + bias));
                        w1.x = cvt_pk_bf16(bf_lo(uu1[q].x) * (acc1[4 * q + 0] + bias), bf_hi(uu1[q].x) * (acc1[4 * q + 1] + bias)); w1.y = cvt_pk_bf16(bf_lo(uu1[q].y) * (acc1[4 * q + 2] + bias), bf_hi(uu1[q].y) * (acc1[4 * q + 3] + bias));
                        *(u32x2*)(Gb + orow_ + q * 8) = w0; *(u32x2*)(Gb + orow_ + 32 + q * 8) = w1; }
                    __syncthreads();
                }
            }
        }
        if (BOTH(3)) GRID_BAR();
    }
    if (IN(4)) {
        PH_CTX();
        pg8::DenseOrder S; S.init(ws + WS_AO, ws + WS_WPA8, T, DM, DA / 2, F.G, bx_, ((REP_GEMM >> 4) & 1) + 1);
        EpiGate<false> E{(const bf16_t*)(ws + WS_GA), (bf16_t*)(ws + WS_MG)};
        pg8::gemm_phase<EpiGate<false>, pg8::DenseOrder, true, true, true>(F.lds + RING_OFF, DA / 2, S, E, F.tid);
    }
    if (IN(5)) {
        PH_CTX();
        pg8::DenseOrder S; S.init(ws + WS_GO, ws + WS_WPB, T, DM, DS, F.G, bx_);
        EpiGate<true> E{(const bf16_t*)(ws + WS_GS), (bf16_t*)(ws + WS_MG)};
        pg8::gemm_phase<EpiGate<true>, pg8::DenseOrder, true, true>(F.lds + RING_OFF, DS, S, E, F.tid);
        if (BOTH(5)) GRID_BAR();
    }
    if (IN(6)) {
        PH_CTX();
        pg8::DenseOrder S; S.init(ws + WS_MG, ws + WS_WOUT, T, DM, DM, F.G, bx_, ((REP_GEMM >> 6) & 1) + 1);
        EpiResNorm E{KARG_IN(0), KARG_IN(10), H, ws + WS_H8, (float*)(F.ctl + CW_SS)};
        pg8::gemm_phase<EpiResNorm, pg8::DenseOrder, true, true>(F.lds + RING_OFF, DM, S, E, F.tid);
        if (BOTH(6)) GRID_BAR();
    }
    if (IN(7)) {
        PH_CTX();
        { pg8::DenseOrder S; S.init(H, ws + WS_WR, T, 256, DM, F.G, bx_);
          EpiLogits E{(float*)(ws + WS_LOG)};
          pg8::gemm_phase<EpiLogits, pg8::DenseOrder, false, true>(F.lds + RING_OFF, DM, S, E, F.tid); }
        __syncthreads();
        CONV_LOOP((unsigned*)nullptr, 0, 4);
        if (BOTH(7)) GRID_BAR();
    }
    if (IN(8)) { if (BOTH(8)) {   } }
    if (IN(9)) {
        PH_CTX();
        const float* LG = (const float*)(ws + WS_LOG); const float* brg = KARG_IN(12); const float* bre = KARG_IN(14);
        float* TW = (float*)(ws + WS_TOKW); int* LIST = (int*)(ws + WS_LIST); unsigned* CNT = F.ctl + CW_CNT; const float* SSQ = (const float*)(F.ctl + CW_SS);
        LAS unsigned* lcnt = (LAS unsigned*)(F.lds + RING_OFF);
        for (int base_t = F.vcu * 128; base_t < T; base_t += F.G * 128) {
            if (F.tid < 64) lcnt[F.tid] = 0u;
            __syncthreads();
            const int t = base_t + F.tid; const bool act = F.tid < 128 && t < T;
            int e0 = 0, e1 = 0; unsigned r0 = 0, r1 = 0; float w0 = 0.f, w1 = 0.f, rstd_t = 0.f;
            if (act) {
            const float* lr = LG + (size_t)t * 64; const float rstd = 1.0f / sqrtf(SSQ[t] * (1.f / DM) + EPS); rstd_t = rstd;
            float gl[4];
#pragma unroll
            for (int j = 0; j < 4; ++j) gl[j] = lr[j] * rstd + brg[j];
            float gmax = gl[0]; int grp = 0;
#pragma unroll
            for (int j = 1; j < 4; ++j) { const bool gt = gl[j] > gmax; gmax = gt ? gl[j] : gmax; grp = gt ? j : grp; }
            float gs = 0.f;
#pragma unroll
            for (int j = 0; j < 4; ++j) gs += __expf(gl[j] - gmax);
            const float p_grp = 1.0f / gs;
            float el[8];
#pragma unroll
            for (int j = 0; j < 8; ++j) el[j] = lr[4 + grp * 8 + j] * rstd + bre[grp * 8 + j];
            float b0 = el[0]; int i0 = 0;
#pragma unroll
            for (int j = 1; j < 8; ++j) { const bool gt = el[j] > b0; b0 = gt ? el[j] : b0; i0 = gt ? j : i0; }
            float b1 = -__builtin_inff(); int i1 = 0;
#pragma unroll
            for (int j = 0; j < 8; ++j) { const bool gt = (j != i0) && (el[j] > b1); b1 = gt ? el[j] : b1; i1 = gt ? j : i1; }
            const float d = __expf(b1 - b0);
            w0 = p_grp / (1.0f + d); w1 = p_grp * d / (1.0f + d);
            e0 = grp * 8 + i0; e1 = grp * 8 + i1;
            r0 = __hip_atomic_fetch_add(lcnt + e0, 1u, __ATOMIC_RELAXED, __HIP_MEMORY_SCOPE_WORKGROUP); r1 = __hip_atomic_fetch_add(lcnt + e1, 1u, __ATOMIC_RELAXED, __HIP_MEMORY_SCOPE_WORKGROUP);
            }
            __syncthreads();
            if (F.tid < 32) { const unsigned cn = lcnt[F.tid]; lcnt[32 + F.tid] = cn ? atomicAdd(CNT + 64 * F.tid, cn) : 0u; }
            __syncthreads();
            if (act) { const unsigned p0 = lcnt[32 + e0] + r0, p1 = lcnt[32 + e1] + r1;
                LIST[(size_t)e0 * T + p0] = 2 * t; LIST[(size_t)e1 * T + p1] = 2 * t + 1; TW[2 * t] = w0; TW[2 * t + 1] = w1;
                float* LISTR = (float*)(ws + WS_LISTR); LISTR[(size_t)e0 * T + p0] = rstd_t; LISTR[(size_t)e1 * T + p1] = rstd_t; }
            __syncthreads();
        }
        if (BOTH(9)) GRID_BAR();
    }
    if (IN(10) || IN(11)) {
        PH_CTX();
        LAS int* tab = (LAS int*)(F.lds + TAB_OFF);
        if (F.tid < NE) tab[961 + F.tid] = (int)__hip_atomic_load(F.ctl + CW_CNT + 64 * F.tid, RLX_AGENT);
        __syncthreads();
        if (F.tid == 0) { int nrb = 0;
            for (int e = 0; e < NE; ++e) { const int c = tab[961 + e];
                for (int p = 0; p < c; p += 256) { tab[nrb] = e; tab[320 + nrb] = e * T + p; tab[640 + nrb] = (c - p) < 256 ? (c - p) : 256; ++nrb; } }
            tab[960] = nrb; }
        __syncthreads();
        const int nrb = __builtin_amdgcn_readfirstlane(tab[960]);
        if (IN(10)) {
            MoeOrder<true> S; S.tab = tab; S.nrb = nrb; S.G = F.G; S.vcu = F.vcu; S.A = (const char*)(ws + WS_H8); S.Bt = (const char*)(ws + WS_WGU); S.a_rb_bytes = 0; S.b_e_bytes = (size_t)DM * DM; S.b_pn_bytes = (size_t)256 * DM; S.list = (const int*)(ws + WS_LIST);
            { LAS unsigned* rt = (LAS unsigned*)(F.lds + RING_BYTES);
              S.rowtab = rt;
#pragma unroll 1
              for (int i = 0; i < 9; ++i) { pg8::Unit u; const bool ok = S.next(i, u); if (!ok) break;
                  if (F.tid < 256) { const int r = F.tid; const int a = S.list[u.x0 + (r < u.x1 ? r : 0)]; rt[i * 256 + r] = (unsigned)(a >> 1) * (unsigned)DM; } }
              __syncthreads(); }
            EpiSwiglu E{ws + WS_HID, (const float*)(ws + WS_LISTR)};
            pg8::gemm_phase<EpiSwiglu, MoeOrder<true>, true, true, true>(F.lds + RING_OFF, DM / 2, S, E, F.tid);
            if (BOTH(10)) GRID_BAR();
        }
        if (IN(11)) {
            MoeOrder<false> S; S.tab = tab; S.nrb = nrb; S.G = F.G; S.vcu = F.vcu; S.A = (const char*)(ws + WS_HID); S.Bt = (const char*)(ws + WS_WD); S.a_rb_bytes = (size_t)256 * FF; S.b_e_bytes = (size_t)DM * FF; S.b_pn_bytes = (size_t)256 * FF; S.list = (const int*)(ws + WS_LIST);
            EpiScatter E{(const int*)(ws + WS_LIST), ws + WS_Y};
            pg8::gemm_phase<EpiScatter, MoeOrder<false>, true, true, true>(F.lds + RING_OFF, FF / 2, S, E, F.tid);
            if (BOTH(11)) GRID_BAR();
        }
    }
    if (IN(12)) {
        PH_CTX();
        const unsigned char* Y = ws + WS_Y; const float* TW = (const float*)(ws + WS_TOKW); const f32x4* gf = (const f32x4*)KARG_IN(18) + F.lane; const f32x4* gn = (const f32x4*)KARG_IN(10) + F.lane;
        bool poison = (__hip_atomic_load(F.ctl + CW_TMO, RLX_AGENT) != 0u);
        if (N_LAUNCHES != PER_PHASE) for (int li = 0; li < N_LAUNCHES; ++li) poison |= __hip_atomic_load(F.ctl + CW_BAR + li * XCD_BAR_WORDS + XB_TMO, RLX_AGENT) != 0u;
        f32x4 ign[8], gfin[8];
#pragma unroll
        for (int j = 0; j < 8; ++j) { const f32x4 gg = gn[64 * j]; ign[j] = (f32x4){__builtin_amdgcn_rcpf(gg.x), __builtin_amdgcn_rcpf(gg.y), __builtin_amdgcn_rcpf(gg.z), __builtin_amdgcn_rcpf(gg.w)}; gfin[j] = gf[64 * j]; }
        for (int m0_ = gw; m0_ < T * REP_P12; m0_ += NGW) { const int m = m0_ % T;
            const u32x2* hr = (const u32x2*)(H + (size_t)m * DM) + F.lane; const unsigned* y0 = (const unsigned*)(Y + (size_t)(2 * m) * DM) + F.lane; const unsigned* y1 = (const unsigned*)(Y + (size_t)(2 * m + 1) * DM) + F.lane;
            f32x4* orow = (f32x4*)(F.out + (size_t)m * DM) + F.lane;
            const float w0 = TW[2 * m], w1 = TW[2 * m + 1];
            f32x4 v[8]; float s = 0.f;
#pragma unroll
            for (int j = 0; j < 8; ++j) { const u32x2 hv = __builtin_nontemporal_load(hr + 64 * j); const unsigned a = __builtin_nontemporal_load(y0 + 64 * j), b = __builtin_nontemporal_load(y1 + 64 * j); const f32x4 ig = ign[j];
                const f32x2 a01 = __builtin_amdgcn_cvt_pk_f32_fp8((int)a, false), a23 = __builtin_amdgcn_cvt_pk_f32_fp8((int)a, true), b01 = __builtin_amdgcn_cvt_pk_f32_fp8((int)b, false), b23 = __builtin_amdgcn_cvt_pk_f32_fp8((int)b, true);
                v[j].x = bf_lo(hv.x) * ig.x + w0 * a01[0] + w1 * b01[0]; v[j].y = bf_hi(hv.x) * ig.y + w0 * a01[1] + w1 * b01[1];
                v[j].z = bf_lo(hv.y) * ig.z + w0 * a23[0] + w1 * b23[0]; v[j].w = bf_hi(hv.y) * ig.w + w0 * a23[1] + w1 * b23[1];
                s += (v[j].x * v[j].x + v[j].y * v[j].y) + (v[j].z * v[j].z + v[j].w * v[j].w); }
            const float rstd = 1.0f / sqrtf(wave_sum(s) * (1.f / DM) + EPS);
#pragma unroll
            for (int j = 0; j < 8; ++j) { const f32x4 g = gfin[j]; f32x4 o = v[j] * rstd * g; if (poison) { const float qn = __builtin_nanf(""); o = (f32x4){qn, qn, qn, qn}; } orow[64 * j] = o; }
        }
    }
#undef IN
#undef BOTH
#undef GRID_BAR
}

extern "C" void kernel_launch(void* const* d_in, const int* in_sizes, int n_in, void* d_out, int out_size, void* d_ws, size_t ws_size, hipStream_t stream) {
    static int grid = 0;
    if (grid == 0) {
        if (n_in != 19 || in_sizes[0] != T * DM || out_size != T * DM || ws_size < WS_END) { fprintf(stderr, "kernel_launch: unexpected shapes (n_in %d, in0 %d, out %d, ws %zu < %zu?); nothing launched\n", n_in, n_in > 0 ? in_sizes[0] : -1, out_size, ws_size, (size_t)WS_END); grid = -1; return; }
        int dev = 0, cus = 0, per_cu = 0;
        if (hipGetDevice(&dev) != hipSuccess || hipDeviceGetAttribute(&cus, hipDeviceAttributeMultiprocessorCount, dev) != hipSuccess) { fprintf(stderr, "kernel_launch: device query failed\n"); grid = -1; return; }
        if (hipFuncSetAttribute((const void*)fwd_kernel, hipFuncAttributeMaxDynamicSharedMemorySize, LDS_BYTES) != hipSuccess) { fprintf(stderr, "kernel_launch: hipFuncSetAttribute failed\n"); grid = -1; return; }
        if (hipOccupancyMaxActiveBlocksPerMultiprocessor(&per_cu, (const void*)fwd_kernel, NWAVES * 64, LDS_BYTES) != hipSuccess || per_cu < 1)
            fprintf(stderr, "kernel_launch: note: occupancy query reports %d workgroups per CU\n", per_cu);
        (void)hipGetLastError();
        grid = cus;
    }
    if (grid < 0) return;
    if (hipMemsetAsync((char*)d_ws + WS_CTL, 0, CTL_ZERO_BYTES, stream) != hipSuccess) { fprintf(stderr, "kernel_launch: memset failed\n"); return; }
    Args a{};
    for (int i = 0; i < 19; ++i) a.in[i] = (const float*)d_in[i];
    a.out = (float*)d_out; a.ws = (unsigned char*)d_ws;
    static_assert(N_LAUNCHES == 1 || N_LAUNCHES == PER_PHASE, "MK_N_LAUNCHES: 1 or 13");
    for (int li = 0; li < N_LAUNCHES; ++li) {
        a.ph_lo = (N_LAUNCHES == PER_PHASE) ? li : 0; a.ph_hi = (N_LAUNCHES == PER_PHASE) ? li + 1 : PER_PHASE; a.li = (N_LAUNCHES == PER_PHASE) ? 0 : li;
        hipLaunchKernelGGL(fwd_kernel, dim3(grid), dim3(NWAVES * 64), LDS_BYTES, stream, a);
        const hipError_t le = hipPeekAtLastError();
        if (le != hipSuccess) { fprintf(stderr, "kernel_launch: launch %d failed: %s\n", li, hipGetErrorName(le)); break; }
    }
}
```

```cpp
#include <hip/hip_runtime.h>
#include <cstdio>
#include <cstdint>
#include <cstddef>

#ifndef REP_GEMM
#define REP_GEMM 0
#endif
#ifndef REP_MOE
#define REP_MOE 1
#endif
#ifndef REP_ATT
#define REP_ATT 1
#endif
#ifndef REP_SGU
#define REP_SGU 1
#endif
#ifndef REP_P7
#define REP_P7 1
#endif
#ifndef REP_P0
#define REP_P0 1
#endif
#ifndef REP_P12
#define REP_P12 1
#endif
#ifndef REP_A2
#define REP_A2 1
#endif
#ifndef ATT_CLAMP
#define ATT_CLAMP 0
#endif
#ifndef ATT_SUB
#define ATT_SUB 2
#endif
#ifndef ATT_STAGE
#define ATT_STAGE 3
#endif
#ifndef NT8
#define NT8 28
#endif
#ifndef MK_N_LAUNCHES
#define MK_N_LAUNCHES 1
#endif

#define LAS __attribute__((address_space(3)))
#define GAS __attribute__((address_space(1)))
typedef unsigned short bf16_t;
typedef short bf16x8 __attribute__((ext_vector_type(8)));
typedef short s16x4 __attribute__((ext_vector_type(4)));
typedef float f32x4 __attribute__((ext_vector_type(4)));
typedef float f32x2 __attribute__((ext_vector_type(2)));
typedef float f32x16 __attribute__((ext_vector_type(16)));
typedef unsigned u32x4 __attribute__((ext_vector_type(4)));
typedef unsigned u32x2 __attribute__((ext_vector_type(2)));

constexpr int BATCH = 8, SEQ = 4096, DM = 2048, T = BATCH * SEQ;
constexpr int NH = 8, HD = 128, DA = 1024, DS = 1024, NPROJ = 9216;
constexpr int MOBA_BLK = 256, NBLK = SEQ / MOBA_BLK;
constexpr int SGU_CHUNK = 128, SGU_G = 8;
constexpr int NE = 32, NEG = 4, EPG = 8, FF = 1024, NASSIGN = 2 * T;
constexpr int MAXRB = NASSIGN / 256 + NE;
constexpr float EPS = 1e-6f;

__device__ __forceinline__ unsigned cvt_pk_bf16(float lo, float hi) { unsigned r; asm volatile("v_cvt_pk_bf16_f32 %0, %1, %2" : "=v"(r) : "v"(lo), "v"(hi)); return r; }
__device__ __forceinline__ float bf_lo(unsigned w) { return __uint_as_float(w << 16); }
__device__ __forceinline__ float bf_hi(unsigned w) { return __uint_as_float(w & 0xffff0000u); }
__device__ __forceinline__ float sigmoid_f(float x) { return __builtin_amdgcn_rcpf(1.0f + __builtin_amdgcn_exp2f(-1.4426950408889634f * x)); }
__device__ __forceinline__ float gelu_tanh_f(float x) { const float y = 1.5957691216057308f * (x + 0.044715f * x * x * x); return x * sigmoid_f(y); }
__device__ __forceinline__ float silu_f(float x) { return x * sigmoid_f(x); }

namespace pg8 {
constexpr int BM = 256, BK = 64, HALF = 128, HTB = HALF * BK * 2  , STAGE_BYTES = 8 * HTB;
__host__ __device__ __forceinline__ int lds_byte(int r, int c) { const int st = (r >> 4) * 2 + (c >> 5), rr = r & 15, cc = c & 31, ob = rr * 64 + cc * 2; return st * 1024 + (ob ^ (((ob >> 9) & 1) << 5)); }
__host__ __device__ __forceinline__ void stage_rc(int b, int& R, int& C) { const int st = b / 1024, sb = b % 1024, swz = sb ^ (((sb >> 9) & 1) << 5); R = (st >> 1) * 16 + swz / 64; C = (st & 1) * 32 + (swz % 64) / 2; }
__host__ __device__ __forceinline__ int perm32(int rho) { const int n = rho >> 4, i = rho & 15; return 8 * (i >> 2) + 4 * n + (i & 3); }

typedef int i32x8 __attribute__((ext_vector_type(8)));
typedef int i32x4 __attribute__((ext_vector_type(4)));
__device__ __forceinline__ i32x8 cat8(bf16x8 a, bf16x8 b) { return __builtin_shufflevector(__builtin_bit_cast(i32x4, a), __builtin_bit_cast(i32x4, b), 0, 1, 2, 3, 4, 5, 6, 7); }
struct Unit { int pm, pn; const char* A; const char* B; int x0, x1, x2; };

template <class Epi, class Sched, bool ALIGN_EPI, bool SP2, bool FP8 = false>
__device__ __forceinline__ void gemm_phase(LAS unsigned char* lds, const int K, const Sched& S, const Epi& E, const int tid) {
    const int wid = __builtin_amdgcn_readfirstlane(tid >> 6), lane = tid & 63, wr = wid >> 2, wc = wid & 3, fr = lane & 15, fq = lane >> 4;
    const int nt = K / BK;
    constexpr bool GATHER = Sched::GATHER;
    unsigned vA[2][2], voffB[2]; int RA[2], CA[2];
#pragma unroll
    for (int i = 0; i < 2; ++i) { int R, C; stage_rc(tid * 16 + i * 8192, R, C); const int Rb = Epi::PERM ? ((R & ~31) + perm32(R & 31)) : R;
        RA[i] = R; CA[i] = C * 2; voffB[i] = (unsigned)(Rb * K + C) * 2u;
        vA[0][i] = (unsigned)(R * K + C) * 2u; vA[1][i] = (unsigned)((R + HALF) * K + C) * 2u; }
    const size_t kstep = (size_t)(BK * 2);
    const size_t hstep = (size_t)HALF * K * 2;
    const unsigned ldsw = (unsigned)wid * 1024u;
    const int aoff = lds_byte(wr * 64 + fr, fq * 8), boff = lds_byte(wc * 32 + fr, fq * 8);
#define PG8_SA(b, h) (((b) * 2 + (h)) * HTB)
#define PG8_SB(b, h) ((4 + (b) * 2 + (h)) * HTB)
#define PG8_STAGE(bufoff, gbase, voff) do { _Pragma("unroll") for (int _i = 0; _i < 2; ++_i) \
        __builtin_amdgcn_global_load_lds((const unsigned*)((const char*)(gbase) + (voff)[_i]), (LAS unsigned*)(lds + (bufoff) + ldsw + _i * 8192), 16, 0, 0); } while (0)
#define PG8_LDA(dst, b, h) do { _Pragma("unroll") for (int m = 0; m < 4; ++m) _Pragma("unroll") for (int k = 0; k < 2; ++k) dst[m][k] = *(const LAS bf16x8*)(lds + PG8_SA(b, h) + aoff + m * 2048 + k * 1024); } while (0)
#define PG8_LDB(dst, b, h) do { _Pragma("unroll") for (int n = 0; n < 2; ++n) _Pragma("unroll") for (int k = 0; k < 2; ++k) dst[n][k] = *(const LAS bf16x8*)(lds + PG8_SB(b, h) + boff + n * 2048 + k * 1024); } while (0)
#define PG8_MMA(ai, bj, At, Bt) do { __builtin_amdgcn_s_setprio(1); _Pragma("unroll") for (int m = 0; m < 4; ++m) _Pragma("unroll") for (int n = 0; n < 2; ++n) { \
        if constexpr (FP8) { asm volatile("v_mfma_scale_f32_16x16x128_f8f6f4 %0, %1, %2, %0, %3, %4 op_sel_hi:[0,0,0]" : "+v"(acc[ai][bj][m][n]) : "v"(cat8(Bt[n][0], Bt[n][1])), "v"(cat8(At[m][0], At[m][1])), "v"(sc_w), "v"(sc_a)); } \
        else { _Pragma("unroll") for (int k = 0; k < 2; ++k) acc[ai][bj][m][n] = __builtin_amdgcn_mfma_f32_16x16x32_bf16(Bt[n][k], At[m][k], acc[ai][bj][m][n], 0, 0, 0); } } __builtin_amdgcn_s_setprio(0); } while (0)
#define PG8_WAIT_V(n) asm volatile("s_waitcnt vmcnt(" #n ")" ::: "memory")
#define PG8_WAIT_L(n) asm volatile("s_waitcnt lgkmcnt(" #n ")" ::: "memory")
#define PG8_BAR __builtin_amdgcn_s_barrier()
#define PG8_SCHED __builtin_amdgcn_sched_barrier(0)
    Unit cur, nxt; int ui = 0;
    if (!S.next(0, cur)) return;
    f32x4 acc[2][2][4][2];
#pragma unroll
    for (int a = 0; a < 2; ++a)
#pragma unroll
        for (int b = 0; b < 2; ++b)
#pragma unroll
            for (int m = 0; m < 4; ++m)
#pragma unroll
                for (int n = 0; n < 2; ++n) acc[a][b][m][n] = (f32x4){0.f, 0.f, 0.f, 0.f};
    bf16x8 At[4][2], B0[2][2], B1[2][2];
    int sc_w = 0x7A7A7A7A, sc_a = 0x7F7F7F7F;
    if constexpr (FP8) asm volatile("" : "+v"(sc_w), "+v"(sc_a));
    const char* cA = cur.A; const char* cB = cur.B;
    if constexpr (GATHER) {
#pragma unroll
        for (int h = 0; h < 2; ++h)
#pragma unroll
            for (int i = 0; i < 2; ++i) vA[h][i] = S.row_off(cur, 0, h * HALF + RA[i]) + (unsigned)CA[i];
    }
    if constexpr (SP2) {
        PG8_STAGE(PG8_SB(0, 0), cB, voffB); PG8_STAGE(PG8_SB(0, 1), cB + hstep, voffB); PG8_STAGE(PG8_SA(0, 0), cA, vA[0]); PG8_STAGE(PG8_SA(0, 1), cA, vA[1]);
        if (wr == 1) PG8_BAR;
        PG8_WAIT_V(2); PG8_BAR;
        PG8_STAGE(PG8_SB(1, 0), cB + kstep, voffB); PG8_STAGE(PG8_SA(1, 0), cA + kstep, vA[0]); PG8_STAGE(PG8_SB(1, 1), cB + hstep + kstep, voffB);
        PG8_WAIT_V(6); PG8_BAR;
    } else {
        PG8_STAGE(PG8_SB(0, 0), cB, voffB); PG8_STAGE(PG8_SA(0, 0), cA, vA[0]); PG8_STAGE(PG8_SB(0, 1), cB + hstep, voffB); PG8_STAGE(PG8_SA(0, 1), cA, vA[1]);
        if (wr == 1) PG8_BAR;
        PG8_WAIT_V(4); PG8_BAR;
        PG8_STAGE(PG8_SB(1, 0), cB + kstep, voffB); PG8_STAGE(PG8_SA(1, 0), cA + kstep, vA[0]); PG8_STAGE(PG8_SB(1, 1), cB + hstep + kstep, voffB);
        PG8_WAIT_V(6); PG8_BAR;
    }
    for (;;) {
        const bool has_next = S.next(ui + 1, nxt);
        const char* nA = has_next ? nxt.A : cA; const char* nB = has_next ? nxt.B : cB;
        for (int t = 0; t < nt; t += 2) {
            const bool last = (t == nt - 2);
            const char* a1 = cA + (size_t)(t + 1) * kstep;
            const char* a2 = last ? nA : cA + (size_t)(t + 2) * kstep; const char* b2 = last ? nB : cB + (size_t)(t + 2) * kstep;
            const char* a3 = a2 + kstep; const char* b3 = b2 + kstep;
            unsigned vNx[2][2];
            if constexpr (GATHER) {
                if (last && has_next) { int t2 = tid; asm volatile("" : "+v"(t2));
#pragma unroll
                    for (int i = 0; i < 2; ++i) { int R2, C2; stage_rc(t2 * 16 + i * 8192, R2, C2);
#pragma unroll
                        for (int h = 0; h < 2; ++h) vNx[h][i] = S.row_off(nxt, ui + 1, h * HALF + R2) + (unsigned)(C2 * 2); }
                }
            }
#define PG8_SWITCH() do { if constexpr (GATHER) { if (last && has_next) { _Pragma("unroll") for (int h = 0; h < 2; ++h) _Pragma("unroll") for (int i = 0; i < 2; ++i) vA[h][i] = vNx[h][i]; } } } while (0)
            if constexpr (SP2) {
            PG8_LDB(B0, 0, 0); PG8_LDB(B1, 0, 1); PG8_SCHED; PG8_LDA(At, 0, 0); PG8_STAGE(PG8_SA(1, 1), a1, vA[1]); PG8_SWITCH();
            PG8_WAIT_V(8); PG8_WAIT_L(0); PG8_BAR; PG8_MMA(0, 0, At, B0); PG8_MMA(0, 1, At, B1); PG8_BAR; PG8_SCHED;
            PG8_LDA(At, 0, 1); PG8_STAGE(PG8_SB(0, 0), b2, voffB); PG8_STAGE(PG8_SB(0, 1), b2 + hstep, voffB); PG8_STAGE(PG8_SA(0, 0), a2, vA[0]);
            PG8_WAIT_V(8); PG8_WAIT_L(0); PG8_BAR; PG8_MMA(1, 0, At, B0); PG8_MMA(1, 1, At, B1); PG8_BAR; PG8_SCHED;
            PG8_LDB(B0, 1, 0); PG8_LDB(B1, 1, 1); PG8_SCHED; PG8_LDA(At, 1, 0); PG8_STAGE(PG8_SA(0, 1), a2, vA[1]);
            PG8_WAIT_V(8); PG8_WAIT_L(0); PG8_BAR; PG8_MMA(0, 0, At, B0); PG8_MMA(0, 1, At, B1); PG8_BAR; PG8_SCHED;
            PG8_LDA(At, 1, 1); PG8_STAGE(PG8_SB(1, 0), b3, voffB); PG8_STAGE(PG8_SB(1, 1), b3 + hstep, voffB); PG8_STAGE(PG8_SA(1, 0), a3, vA[0]);
            PG8_WAIT_V(8); PG8_WAIT_L(0); PG8_BAR; PG8_MMA(1, 0, At, B0); PG8_MMA(1, 1, At, B1); PG8_BAR; PG8_SCHED;
            } else {
            PG8_LDB(B0, 0, 0); PG8_SCHED; PG8_LDA(At, 0, 0); PG8_STAGE(PG8_SA(1, 1), a1, vA[1]); PG8_SWITCH();
            PG8_WAIT_L(8); PG8_BAR; PG8_WAIT_L(0); PG8_MMA(0, 0, At, B0); PG8_BAR; PG8_SCHED;
            PG8_LDB(B1, 0, 1); PG8_STAGE(PG8_SB(0, 0), b2, voffB);
            PG8_BAR; PG8_WAIT_L(0); PG8_MMA(0, 1, At, B1); PG8_BAR;
            PG8_LDA(At, 0, 1); PG8_STAGE(PG8_SA(0, 0), a2, vA[0]);
            PG8_BAR; PG8_WAIT_L(0); PG8_MMA(1, 0, At, B0); PG8_BAR; PG8_SCHED;
            PG8_STAGE(PG8_SB(0, 1), b2 + hstep, voffB);
            PG8_WAIT_V(6); PG8_BAR; PG8_MMA(1, 1, At, B1); PG8_BAR;
            PG8_LDB(B0, 1, 0); PG8_SCHED; PG8_LDA(At, 1, 0); PG8_STAGE(PG8_SA(0, 1), a2, vA[1]);
            PG8_WAIT_L(8); PG8_BAR; PG8_WAIT_L(0); PG8_MMA(0, 0, At, B0); PG8_BAR; PG8_SCHED;
            PG8_LDB(B1, 1, 1); PG8_STAGE(PG8_SB(1, 0), b3, voffB);
            PG8_BAR; PG8_WAIT_L(0); PG8_MMA(0, 1, At, B1); PG8_BAR;
            PG8_LDA(At, 1, 1); PG8_STAGE(PG8_SA(1, 0), a3, vA[0]);
            PG8_BAR; PG8_WAIT_L(0); PG8_MMA(1, 0, At, B0); PG8_BAR; PG8_SCHED;
            PG8_STAGE(PG8_SB(1, 1), b3 + hstep, voffB);
            PG8_WAIT_V(6); PG8_BAR; PG8_MMA(1, 1, At, B1); PG8_BAR;
            }
        }
        if constexpr (ALIGN_EPI) { if (wr == 0) PG8_BAR; }
        if constexpr (FP8) asm volatile("s_nop 15\n\ts_nop 15" ::: "memory");
        E(acc, cur, wr, wc, fr, fq);
        if (!has_next) break;
#pragma unroll
        for (int a = 0; a < 2; ++a)
#pragma unroll
            for (int b = 0; b < 2; ++b)
#pragma unroll
                for (int m = 0; m < 4; ++m)
#pragma unroll
                    for (int n = 0; n < 2; ++n) acc[a][b][m][n] = (f32x4){0.f, 0.f, 0.f, 0.f};
        cur = nxt; cA = nA; cB = nB; ++ui;
        if constexpr (ALIGN_EPI) { if (wr == 1) PG8_BAR; }
    }
    PG8_WAIT_V(0);
    if constexpr (!ALIGN_EPI) { if (wr == 0) PG8_BAR; }
    PG8_BAR;
#undef PG8_SA
#undef PG8_SB
#undef PG8_STAGE
#undef PG8_LDA
#undef PG8_LDB
#undef PG8_MMA
#undef PG8_WAIT_V
#undef PG8_WAIT_L
#undef PG8_BAR
#undef PG8_SCHED
#undef PG8_SWITCH
}

constexpr int NXCD = 8, WGM = 8;
struct DenseOrder {
    static constexpr bool GATHER = false;
    const char* A; const char* Bt; int K, nM, nN, nwg, G, c, reps, skip_from, skip_len;
    __device__ __forceinline__ void init(const void* A_, const void* Bt_, int M, int N, int K_, int G_, int c_, int reps_ = 1, int skip_from_ = 1 << 20, int skip_len_ = 0) { A = (const char*)A_; Bt = (const char*)Bt_; K = K_; nM = M / BM; nN = N / BM; nwg = nM * nN; G = G_; c = c_; reps = reps_; skip_from = skip_from_; skip_len = skip_len_; }
    __device__ __forceinline__ bool next(int i, Unit& u) const {
        const long L = (long)i * G + c; if (L >= (long)nwg * reps) return false;
        int wgid = (int)(L % nwg); { const int q = nwg / NXCD, r = nwg % NXCD, xcd = wgid % NXCD, off = wgid / NXCD; wgid = (xcd < r ? xcd * (q + 1) : r * (q + 1) + (xcd - r) * q) + off; }
        const int nig = WGM * nN, gid = wgid / nig, fm = gid * WGM, gsz = (nM - fm) < WGM ? (nM - fm) : WGM;
        u.pm = fm + ((wgid % nig) % gsz); u.pn = (wgid % nig) / gsz; if (u.pn >= skip_from) u.pn += skip_len;
        u.A = A + (size_t)u.pm * BM * K * 2; u.B = Bt + (size_t)u.pn * BM * K * 2; u.x0 = 0; u.x1 = 0; u.x2 = (L >= nwg) ? 1 : 0; return true;
    }
    __device__ __forceinline__ unsigned row_off(const Unit&, int, int) const { return 0u; }
};
}

namespace att {
constexpr int D = 128, LD = 1024, NW = 8, QBLK = 32, KVBLK = 64, QB = 256;
constexpr int SHM_V = KVBLK * D * 2, SHM_K = KVBLK * D * 2;
constexpr int LDS_BYTES = 2 * SHM_V + 2 * SHM_K + NW * 64 * 4;
constexpr float SCALE = 0.08838834764831845f, THR = 8.f;
#define KSWZ(row, colB) ((((colB) >> 7) * 8192) + (row) * 128 + (((colB) & 127) ^ (((((row) >> 1) & 1) | ((((row) >> 3) & 3) << 1)) << 4)))
#define KROW32 (32 * 128)
#define SBAR() __builtin_amdgcn_sched_barrier(0)
__device__ __forceinline__ int v_st(int k, int c) { const int kk = (k & ~0xC) | ((k & 4) << 1) | ((k & 8) >> 1); return ((kk >> 3) * 4 + (c >> 5)) * 512 + ((kk & 7) * 32 + (c & 31)) * 2; }
__device__ __forceinline__ int v_rd_base(int lane) { return ((lane & 3) << 3) | (((lane >> 2) & 3) << 6) | (((lane >> 4) & 1) << 5) | (((lane >> 5) & 1) << 8); }
constexpr int v_rd_off(int d0, int ks, int half) { return d0 * 512 + ks * 4096 + half * 2048; }
__device__ __forceinline__ int crow(int r, int hi) { return (r & 3) + 8 * (r >> 2) + 4 * hi; }
__device__ __forceinline__ bf16x8 load8(const bf16_t* p) { return *reinterpret_cast<const bf16x8*>(p); }
__device__ __forceinline__ void mask_causal(f32x16& p0, f32x16& p1, int dq) {
    const float NEG = -__builtin_inff();
#pragma unroll
    for (int r = 0; r < 16; ++r) { const int c = (r & 3) + 8 * (r >> 2); if (dq - c < 0) p0[r] = NEG; if (dq - c - 32 < 0) p1[r] = NEG; }
}
__device__ __forceinline__ void mask_all(f32x16& p0, f32x16& p1, bool keep) {
    const float NEG = -__builtin_inff();
#pragma unroll
    for (int r = 0; r < 16; ++r) { p0[r] = keep ? p0[r] : NEG; p1[r] = keep ? p1[r] : NEG; }
}
__device__ __forceinline__ void partialSM(f32x16& p0, f32x16& p1, float& m_reg, float& mn, float& alpha) {
    float pmax = p0[0];
#pragma unroll
    for (int r = 1; r < 16; ++r) pmax = fmaxf(pmax, p0[r]);
#pragma unroll
    for (int r = 0; r < 16; ++r) pmax = fmaxf(pmax, p1[r]);
    { auto rr = __builtin_amdgcn_permlane32_swap(__float_as_uint(pmax), __float_as_uint(pmax), false, false);
      pmax = fmaxf(__uint_as_float(rr[0]), __uint_as_float(rr[1])); }
    constexpr float C2 = 1.4426950408889634f * SCALE;
    if (__builtin_expect(__all((pmax - m_reg) * SCALE <= THR), 1)) { mn = m_reg; alpha = 1.f; }
    else { mn = fmaxf(m_reg, pmax); alpha = __builtin_amdgcn_exp2f((m_reg - mn) * C2); m_reg = mn; }
    const float mnL = -mn * C2;
#pragma unroll
    for (int r = 0; r < 16; ++r) p0[r] = fmaf(p0[r], C2, mnL);
#pragma unroll
    for (int r = 0; r < 16; ++r) p1[r] = fmaf(p1[r], C2, mnL);
#pragma unroll
    for (int r = 0; r < 16; ++r) p0[r] = __builtin_amdgcn_exp2f(p0[r]);
}
__device__ __forceinline__ void finishSM(f32x16& p0, f32x16& p1, float alpha, float& l_reg, bf16x8& pa0, bf16x8& pa1, bf16x8& pa2, bf16x8& pa3) {
#pragma unroll
    for (int r = 0; r < 16; ++r) p1[r] = __builtin_amdgcn_exp2f(p1[r]);
    float ps = 0;
#pragma unroll
    for (int r = 0; r < 16; ++r) ps += p0[r];
#pragma unroll
    for (int r = 0; r < 16; ++r) ps += p1[r];
    { auto rr = __builtin_amdgcn_permlane32_swap(__float_as_uint(ps), __float_as_uint(ps), false, false);
      ps = __uint_as_float(rr[0]) + __uint_as_float(rr[1]); }
    l_reg = l_reg * alpha + ps;
#define PK4(P, B_, OUT) do { unsigned a0 = cvt_pk_bf16(P[B_+0], P[B_+1]), a1 = cvt_pk_bf16(P[B_+2], P[B_+3]);                          \
        unsigned b0 = cvt_pk_bf16(P[B_+4], P[B_+5]), b1 = cvt_pk_bf16(P[B_+6], P[B_+7]);                                             \
        auto r0 = __builtin_amdgcn_permlane32_swap(a0, b0, false, false); auto r1 = __builtin_amdgcn_permlane32_swap(a1, b1, false, false); \
        u32x4 w = {r0[0], r1[0], r0[1], r1[1]}; OUT = *reinterpret_cast<bf16x8*>(&w); } while (0)
    PK4(p0, 0, pa0); PK4(p0, 8, pa1); PK4(p1, 0, pa2); PK4(p1, 8, pa3);
#undef PK4
}
template <int KB>
__device__ __forceinline__ void qkt(f32x16& p0, f32x16& p1, const char* K_lds, int r32, int hi, const bf16x8* qr) {
    p0 = f32x16{}; p1 = f32x16{};
    const char* kb[4];
#pragma unroll
    for (int dd = 0; dd < 4; ++dd) kb[dd] = K_lds + KB * SHM_K + KSWZ(r32, (dd * 16 + hi * 8) * 2);
#pragma unroll
    for (int d0 = 0; d0 < 8; ++d0) { const char* a = kb[d0 & 3] + (d0 >> 2) * 8192;
        bf16x8 b0 = *reinterpret_cast<const bf16x8*>(a);
        bf16x8 b1 = *reinterpret_cast<const bf16x8*>(a + KROW32);
        p0 = __builtin_amdgcn_mfma_f32_32x32x16_bf16(b0, qr[d0], p0, 0, 0, 0);
        p1 = __builtin_amdgcn_mfma_f32_32x32x16_bf16(b1, qr[d0], p1, 0, 0, 0); }
}
template <int VB>
__device__ __forceinline__ void pv_tile(f32x16* o, int vb0, bf16x8 pa0, bf16x8 pa1, bf16x8 pa2, bf16x8 pa3) {
#define TRRD(dst, off) asm volatile("ds_read_b64_tr_b16 %0, %1 offset:%2" : "=&v"(dst) : "v"(vb0), "i"(off) : "memory")
#define PV_RD(S_, d0) do { constexpr int b_ = VB * SHM_V + v_rd_off(d0, 0, 0); \
        TRRD(S_[0], b_); TRRD(S_[1], b_ + 2048); TRRD(S_[2], b_ + 4096); TRRD(S_[3], b_ + 6144); TRRD(S_[4], b_ + 8192); TRRD(S_[5], b_ + 10240); TRRD(S_[6], b_ + 12288); TRRD(S_[7], b_ + 14336); } while (0)
#define PV_MF(S_, d0) do { \
        o[d0] = __builtin_amdgcn_mfma_f32_32x32x16_bf16(pa0, (bf16x8){S_[0][0], S_[0][1], S_[0][2], S_[0][3], S_[1][0], S_[1][1], S_[1][2], S_[1][3]}, o[d0], 0, 0, 0);   \
        o[d0] = __builtin_amdgcn_mfma_f32_32x32x16_bf16(pa1, (bf16x8){S_[2][0], S_[2][1], S_[2][2], S_[2][3], S_[3][0], S_[3][1], S_[3][2], S_[3][3]}, o[d0], 0, 0, 0);   \
        o[d0] = __builtin_amdgcn_mfma_f32_32x32x16_bf16(pa2, (bf16x8){S_[4][0], S_[4][1], S_[4][2], S_[4][3], S_[5][0], S_[5][1], S_[5][2], S_[5][3]}, o[d0], 0, 0, 0);   \
        o[d0] = __builtin_amdgcn_mfma_f32_32x32x16_bf16(pa3, (bf16x8){S_[6][0], S_[6][1], S_[6][2], S_[6][3], S_[7][0], S_[7][1], S_[7][2], S_[7][3]}, o[d0], 0, 0, 0); } while (0)
    s16x4 fa[8], fb[8];
    PV_RD(fa, 0);
    PV_RD(fb, 1); asm volatile("s_waitcnt lgkmcnt(8)" ::: "memory"); SBAR(); PV_MF(fa, 0); SBAR();
    PV_RD(fa, 2); asm volatile("s_waitcnt lgkmcnt(8)" ::: "memory"); SBAR(); PV_MF(fb, 1); SBAR();
    PV_RD(fb, 3); asm volatile("s_waitcnt lgkmcnt(8)" ::: "memory"); SBAR(); PV_MF(fa, 2); SBAR();
    asm volatile("s_waitcnt lgkmcnt(0)" ::: "memory"); SBAR(); PV_MF(fb, 3);
#undef PV_RD
#undef PV_MF
#undef TRRD
}
constexpr int WS_OFF = 2 * SHM_V + 2 * SHM_K;
constexpr int OST_OFF = WS_OFF + NW * 1024;
constexpr int LDS_BYTES2 = OST_OFF + NW * 8192;
constexpr int LCAP = 3840;
struct URef { unsigned qoff, koff; int key0; unsigned lbase; int rows; unsigned pbase; };
struct Bases { unsigned char* wsb; unsigned oQ, oK, oV, oO, oPART, oPML, oALIST; };
struct Seam { bf16x8 qr[8]; bf16x8 st_v0, st_v1, st_k0, st_k1; unsigned ent; };
#define LDG8(boff) (*(const bf16x8*)(BS.wsb + (ATT_CLAMP ? (((boff) < 0x3C000000u) ? (boff) : 0x3C000000u) : (boff))))
#define VMW() asm volatile("s_waitcnt vmcnt(0)" ::: "memory")
#define VMWN(n) asm volatile("s_waitcnt vmcnt(%0)" :: "i"(n) : "memory")
#define SLOAD_H(koff_, k0) do { const unsigned ko_ = ((koff_) + (unsigned)(k0) * LD) * 2u;     \
                         S.st_v0 = LDG8(BS.oV + ko_ + kl0); S.st_v1 = LDG8(BS.oV + ko_ + kl1); S.st_k0 = LDG8(BS.oK + ko_ + kl0); S.st_k1 = LDG8(BS.oK + ko_ + kl1); } while (0)
#define SWRITE_HK(bf) do { *(bf16x8*)(K_lds + (bf) * SHM_K + kws) = S.st_k0; *(bf16x8*)(K_lds + (bf) * SHM_K + kws + KROW32) = S.st_k1; } while (0)
#define SWRITE_HV(bf) do { *(bf16x8*)(V_lds + (bf) * SHM_V + vst0) = S.st_v0; *(bf16x8*)(V_lds + (bf) * SHM_V + vst1) = S.st_v1; } while (0)
#define SWRITE_H(bf) do { SWRITE_HV(bf); SWRITE_HK(bf); } while (0)
template <int MODE> __device__ __forceinline__ void q_loads(const Bases& BS, const URef& u, Seam& S, int wid, int r32, int hi) {
    unsigned ql;
    if constexpr (MODE == 1) { int row = wid * QBLK + r32; row = row < u.rows ? row : u.rows - 1; S.ent = *(const unsigned short*)(BS.wsb + (BS.oALIST + (ATT_CLAMP ? ((u.lbase + (unsigned)row) & 0x3FFFFFu) : (u.lbase + (unsigned)row)) * 2u)); ql = (unsigned)((S.ent & 4095u) * LD + hi * 8) * 2u; }
    else ql = (unsigned)((wid * QBLK + r32) * LD + hi * 8) * 2u;
    const unsigned qb_ = BS.oQ + u.qoff * 2u + ql;
#pragma unroll
    for (int d0 = 0; d0 < 8; ++d0) S.qr[d0] = LDG8(qb_ + d0 * 32);
}
template <int MODE> __device__ __forceinline__ void prime(const Bases& BS, const URef& cur, char* lds, Seam& S, const int tid) {
    const int wid = __builtin_amdgcn_readfirstlane(tid >> 6), lane = tid & 63, r32 = lane & 31, hi = lane >> 5;
    const int sr = tid >> 4, sc = (tid & 15) * 8, kws = KSWZ(sr, sc * 2); char* K_lds = lds + 2 * SHM_V;
    const unsigned kl0 = (unsigned)(sr * LD + sc) * 2u, kl1 = kl0 + 32u * LD * 2u;
    q_loads<MODE>(BS, cur, S, wid, r32, hi);
    SLOAD_H(cur.koff, cur.key0); VMW(); SWRITE_HK(0);
    __syncthreads();
}
__device__ __forceinline__ unsigned moba_select(const bf16x8* qr, const bf16_t* KM, int bq, int r32, int hi) {
    f32x16 g = f32x16{};
    const unsigned kml = (unsigned)((r32 & 15) * LD + hi * 8) * 2u;
#pragma unroll
    for (int d0 = 0; d0 < 8; ++d0) { const bf16x8 kf = *(const bf16x8*)((const char*)KM + (kml + d0 * 32));
        g = __builtin_amdgcn_mfma_f32_32x32x16_bf16(kf, qr[d0], g, 0, 0, 0); }
    float gv[16];
#pragma unroll
    for (int r = 0; r < 8; ++r) { auto rr = __builtin_amdgcn_permlane32_swap(__float_as_uint(g[r]), __float_as_uint(g[r]), false, false);
        gv[(r & 3) + 8 * (r >> 2)] = __uint_as_float(rr[0]); gv[(r & 3) + 8 * (r >> 2) + 4] = __uint_as_float(rr[1]); }
    const float NEG = -__builtin_inff();
#pragma unroll
    for (int j = 0; j < 16; ++j) gv[j] = (j < bq) ? gv[j] : NEG;
    unsigned sel = 0u;
#pragma unroll
    for (int it = 0; it < 3; ++it) { float best = NEG; int bi = -1;
#pragma unroll
        for (int j = 0; j < 16; ++j) { const bool gt = gv[j] > best; best = gt ? gv[j] : best; bi = gt ? j : bi; }
        sel |= (bi >= 0) ? (1u << bi) : 0u;
#pragma unroll
        for (int j = 0; j < 16; ++j) gv[j] = (j == bi) ? NEG : gv[j]; }
    return sel;
}
template <int MODE>
__device__ __forceinline__ void block(const Bases& BS, const URef& cur, const URef& nxt, char* lds, Seam& S, const int tid) {
    const int wid = __builtin_amdgcn_readfirstlane(tid >> 6), lane = tid & 63, r32 = lane & 31, hi = lane >> 5;
    constexpr int NT = 4;
    const int qlo = cur.key0 + wid * QBLK, qm = qlo + r32 - 4 * hi;
    char* V_lds = lds; char* K_lds = lds + 2 * SHM_V;
    float* ws = (float*)(lds + WS_OFF) + wid * 256; float* li_l = ws, * al_l = ws + 32; unsigned* entl = (unsigned*)(ws + 64); float* wts = ws + 96;
    char* ost = lds + OST_OFF + wid * 8192;
    float m_reg = -1e30f, l_reg = 0; f32x16 o[4] = {};
    const int sr = tid >> 4, sc = (tid & 15) * 8, vst0 = v_st(sr, sc), vst1 = v_st(32 + sr, sc), kws = KSWZ(sr, sc * 2);
    const unsigned kl0 = (unsigned)(sr * LD + sc) * 2u, kl1 = kl0 + 32u * LD * 2u;
    const int vb0 = (int)(uintptr_t)V_lds + v_rd_base(lane);
    if constexpr (MODE == 1) { if (hi == 0) entl[r32] = S.ent; }
#define RESC(a) do { if (__any((a) < 1.f)) { if (hi == 0) al_l[r32] = (a); asm volatile("s_waitcnt lgkmcnt(0)" ::: "memory");              \
                     for (int d_ = 0; d_ < 4; ++d_) for (int r = 0; r < 16; ++r) o[d_][r] *= al_l[crow(r, hi)]; } } while (0)
#define KBASE(t) (cur.key0 + (t) * KVBLK)
#define MASKT(P0_, P1_, t) do { if constexpr (MODE == 0) { const int kb_ = KBASE(t); if (kb_ + KVBLK - 1 > qlo) mask_causal(P0_, P1_, qm - kb_); } } while (0)
    constexpr int NQL = 8;
#define SEAM_K0() do { VMWN(NQL); SWRITE_HK(0); SBAR(); } while (0)
    f32x16 pA0, pA1, pB0, pB1; float mnA, mnB, alA, alB; bf16x8 pa0, pa1, pa2, pa3;
#if ATT_CLAMP >= 3
    if (true) { l_reg = 1.f; m_reg = 0.f; } else {
#else
    {
#endif
    SWRITE_HV(0); SBAR();
    SLOAD_H(cur.koff, KBASE(1));
    SBAR(); qkt<0>(pA0, pA1, K_lds, r32, hi, S.qr);
    MASKT(pA0, pA1, 0); partialSM(pA0, pA1, m_reg, mnA, alA);
    VMW(); SWRITE_H(1);
    __syncthreads();
#define HALF_STEP(PX0, PX1, mnX, alX, PY0, PY1, alY, t, KB, VB, SB) do {                                                      \
        SBAR(); qkt<KB>(PX0, PX1, K_lds, r32, hi, S.qr);                                             \
        finishSM(PY0, PY1, alY, l_reg, pa0, pa1, pa2, pa3); SBAR();                                                           \
        if ((t) + 1 < NT) { SLOAD_H(cur.koff, KBASE((t) + 1)); SBAR(); }                                               \
        pv_tile<VB>(o, vb0, pa0, pa1, pa2, pa3); MASKT(PX0, PX1, (t)); partialSM(PX0, PX1, m_reg, mnX, alX);                                        \
        __syncthreads();                                                                                                      \
        if ((t) + 1 < NT) { VMW(); SWRITE_H(SB); }                                                                          \
        RESC(alX); __syncthreads(); } while (0)
    HALF_STEP(pB0, pB1, mnB, alB, pA0, pA1, alA, 1, 1, 0, 0);
    HALF_STEP(pA0, pA1, mnA, alA, pB0, pB1, alB, 2, 0, 1, 1);
    { SBAR(); qkt<1>(pB0, pB1, K_lds, r32, hi, S.qr); SBAR(); }
    SLOAD_H(nxt.koff, nxt.key0); SBAR();
    q_loads<MODE>(BS, nxt, S, wid, r32, hi);
    SBAR();
    finishSM(pA0, pA1, alA, l_reg, pa0, pa1, pa2, pa3); SBAR();
    pv_tile<0>(o, vb0, pa0, pa1, pa2, pa3);
    { MASKT(pB0, pB1, NT - 1); partialSM(pB0, pB1, m_reg, mnB, alB); __syncthreads(); RESC(alB);
      finishSM(pB0, pB1, alB, l_reg, pa0, pa1, pa2, pa3); SBAR(); pv_tile<1>(o, vb0, pa0, pa1, pa2, pa3); }
    SBAR(); SEAM_K0();
    }
#if ATT_CLAMP == 4
    __syncthreads(); return;
#endif
    if (hi == 0) li_l[r32] = l_reg; asm volatile("s_waitcnt lgkmcnt(0)" ::: "memory");
    float rli[16];
#pragma unroll
    for (int r = 0; r < 16; ++r) rli[r] = __builtin_amdgcn_rcpf(li_l[crow(r, hi)]);
#pragma unroll
    for (int r = 0; r < 16; ++r) { const int orow = crow(r, hi);
#pragma unroll
        for (int d0 = 0; d0 < 4; ++d0) { const float v = o[d0][r] * rli[r];
            const float vn = __uint_as_float((unsigned)__builtin_amdgcn_update_dpp(0, (int)__float_as_uint(v), 0xB1, 0xF, 0xF, false));
            const unsigned pk = cvt_pk_bf16(v, vn);
            if ((r32 & 1) == 0) *(unsigned*)(ost + (orow * 128 + d0 * 32 + r32) * 2) = pk; } }
    constexpr float C2 = 1.4426950408889634f * SCALE;
    if constexpr (MODE == 1) {
        asm volatile("s_waitcnt lgkmcnt(0)" ::: "memory");
        if ((ATT_SUB >= 2) && hi == 0 && wid * QBLK + r32 < cur.rows) { const unsigned e = entl[r32]; *(f32x2*)(BS.wsb + (BS.oPML + (((cur.pbase + (e & 4095u)) * 3u + (e >> 12) - 1u) << 3))) = (f32x2){m_reg, l_reg}; }
#pragma unroll
        for (int i = 0; i < 8; ++i) { const int row = i * 4 + (lane >> 4), ch = lane & 15; const bf16x8 own = *(const bf16x8*)(ost + (row * 128 + ch * 8) * 2); const unsigned e = entl[row];
            if ((ATT_SUB >= 2) && (ATT_SUB != 4) && wid * QBLK + row < cur.rows) *(bf16x8*)(BS.wsb + (BS.oPART + ((((cur.pbase + (e & 4095u)) * 3u + (e >> 12) - 1u) << 8) + (unsigned)ch * 16u))) = own; }
    } else {
#if ATT_CLAMP == 2
        const int ns = 0;
#else
        const int ns = cur.rows;
#endif
        if (hi == 0) { const unsigned prow = (cur.pbase + (unsigned)(cur.key0 + wid * QBLK + r32)) * 3u; float mk[4], lk[4]; mk[0] = m_reg; lk[0] = l_reg;
#pragma unroll
            for (int s2 = 0; s2 < 3; ++s2) { if (s2 < ns) { const f32x2 t = *(const f32x2*)(BS.wsb + (BS.oPML + ((prow + (unsigned)s2) << 3))); mk[s2 + 1] = t[0]; lk[s2 + 1] = t[1]; } else { mk[s2 + 1] = -1e30f; lk[s2 + 1] = 0.f; } }
            const float M = fmaxf(fmaxf(mk[0], mk[1]), fmaxf(mk[2], mk[3])); float w[4], sum = 0.f;
#pragma unroll
            for (int k = 0; k < 4; ++k) { w[k] = lk[k] * __builtin_amdgcn_exp2f((mk[k] - M) * C2); sum += w[k]; }
            const float inv = __builtin_amdgcn_rcpf(sum);
#pragma unroll
            for (int k = 0; k < 4; ++k) wts[r32 * 4 + k] = w[k] * inv; }
        asm volatile("s_waitcnt lgkmcnt(0)" ::: "memory");
        const unsigned ow_ = BS.oO + cur.qoff + (unsigned)(wid * QBLK) * LD;
#pragma unroll
        for (int i = 0; i < 8; ++i) { const int row = i * 4 + (lane >> 4), ch = lane & 15; const u32x4 own = *(const u32x4*)(ost + (row * 128 + ch * 8) * 2);
            const f32x4 wv = *(const f32x4*)(wts + row * 4);
            float a8[8] = {bf_lo(own.x) * wv[0], bf_hi(own.x) * wv[0], bf_lo(own.y) * wv[0], bf_hi(own.y) * wv[0], bf_lo(own.z) * wv[0], bf_hi(own.z) * wv[0], bf_lo(own.w) * wv[0], bf_hi(own.w) * wv[0]};
            const unsigned pro_ = BS.oPART + (((cur.pbase + (unsigned)(cur.key0 + wid * QBLK + row)) * 3u) << 8) + (unsigned)ch * 16u;
#pragma unroll
            for (int s2 = 0; s2 < 3; ++s2) if (s2 < ns) { const u32x4 p = *(const u32x4*)(BS.wsb + (pro_ + (unsigned)s2 * 256u)); const float wk = wv[s2 + 1];
                a8[0] += bf_lo(p.x) * wk; a8[1] += bf_hi(p.x) * wk; a8[2] += bf_lo(p.y) * wk; a8[3] += bf_hi(p.y) * wk; a8[4] += bf_lo(p.z) * wk; a8[5] += bf_hi(p.z) * wk; a8[6] += bf_lo(p.w) * wk; a8[7] += bf_hi(p.w) * wk; }
            u32x2 w8; w8.x = __builtin_amdgcn_cvt_pk_fp8_f32(a8[2], a8[3], __builtin_amdgcn_cvt_pk_fp8_f32(a8[0], a8[1], 0u, false), true); w8.y = __builtin_amdgcn_cvt_pk_fp8_f32(a8[6], a8[7], __builtin_amdgcn_cvt_pk_fp8_f32(a8[4], a8[5], 0u, false), true);
            *(u32x2*)(BS.wsb + (ow_ + (unsigned)row * LD + (unsigned)ch * 8u)) = w8; }
    }
    __syncthreads();
#undef RESC
#undef KBASE
#undef MASKT
#undef SEAM_K0
#undef HALF_STEP
}
constexpr int R_V = 4 * SHM_K, R_WS = R_V + 4 * SHM_V, R_BYTES = R_WS + NW * 1024;
struct CRef { unsigned qoff; unsigned lbase; int rows; unsigned pbase; int qpos0; int ns; };
struct QState { bf16x8 qr[8]; unsigned ent; };
__device__ __forceinline__ int rb0(int wid) { return wid < 4 ? wid : 11 - wid; }
struct KVRegs { bf16x8 kk[4][2], vv[4][2]; };
__device__ __forceinline__ void load_kv_issue(const Bases& BS, unsigned koff, int key0, const int tid, KVRegs& R) {
    const int sr = tid >> 4, sc = (tid & 15) * 8;
    const unsigned kl0 = (unsigned)(sr * LD + sc) * 2u, kl1 = kl0 + 32u * LD * 2u;
#pragma unroll
    for (int t = 0; t < 4; ++t) { const unsigned ko_ = (koff + (unsigned)(key0 + t * KVBLK) * LD) * 2u;
        R.kk[t][0] = LDG8(BS.oK + ko_ + kl0); R.kk[t][1] = LDG8(BS.oK + ko_ + kl1); R.vv[t][0] = LDG8(BS.oV + ko_ + kl0); R.vv[t][1] = LDG8(BS.oV + ko_ + kl1); }
}
__device__ __forceinline__ void load_kv_commit(char* lds, const int tid, const KVRegs& R) {
    const int sr = tid >> 4, sc = (tid & 15) * 8, vst0 = v_st(sr, sc), vst1 = v_st(32 + sr, sc), kws = KSWZ(sr, sc * 2);
#pragma unroll
    for (int t = 0; t < 4; ++t) { *(bf16x8*)(lds + t * SHM_K + kws) = R.kk[t][0]; *(bf16x8*)(lds + t * SHM_K + kws + KROW32) = R.kk[t][1];
        *(bf16x8*)(lds + R_V + t * SHM_V + vst0) = R.vv[t][0]; *(bf16x8*)(lds + R_V + t * SHM_V + vst1) = R.vv[t][1]; }
}
__device__ __forceinline__ void load_kv(const Bases& BS, unsigned koff, int key0, char* lds, const int tid) { KVRegs R; load_kv_issue(BS, koff, key0, tid, R); load_kv_commit(lds, tid, R); }
template <int MODE> __device__ __forceinline__ void q_loads2(const Bases& BS, const CRef& u, QState& S, int wid, int r32, int hi) {
    unsigned ql;
    if constexpr (MODE == 1) { int row = wid * QBLK + r32; row = row < u.rows ? row : u.rows - 1; S.ent = *(const unsigned short*)(BS.wsb + (BS.oALIST + (u.lbase + (unsigned)row) * 2u)); ql = (unsigned)((S.ent & 4095u) * LD + hi * 8) * 2u; }
    else ql = (unsigned)((wid * QBLK + r32) * LD + hi * 8) * 2u;
    const unsigned qb_ = BS.oQ + u.qoff * 2u + ql;
#pragma unroll
    for (int d0 = 0; d0 < 8; ++d0) S.qr[d0] = LDG8(qb_ + d0 * 32);
}
template <int MODE>
__device__ __forceinline__ void chunk(const Bases& BS, const CRef& cur, const CRef& nxt, const bool has_next, char* lds, QState& S, const int tid, float& mo, float& lo, f32x16 (&o)[4]) {
    const int wid = __builtin_amdgcn_readfirstlane(tid >> 6), lane = tid & 63, r32 = lane & 31, hi = lane >> 5;
    char* K_lds = lds;
    float* ws = (float*)(lds + R_WS) + wid * 256; float* li_l = ws, * al_l = ws + 32; unsigned* entl = (unsigned*)(ws + 64);
    const int vb0 = (int)(uintptr_t)(lds + R_V) + v_rd_base(lane);
    const int wrow = (MODE == 0) ? rb0(wid) : wid;
    const int qlo = cur.qpos0 + wrow * QBLK, qm = qlo + r32 - 4 * hi;
    const bool active = (MODE == 0) || (wid * QBLK < cur.rows);
    float m_reg = -1e30f, l_reg = 0;
#pragma unroll
    for (int d = 0; d < 4; ++d) o[d] = f32x16{};
    if constexpr (MODE == 1) { if (hi == 0) entl[r32] = S.ent; }
    if (active) {
        f32x16 p0, p1; float mn, al; bf16x8 pa0, pa1, pa2, pa3;
#define TILE(t) do { if (MODE == 0 && (t) * KVBLK > wrow * QBLK + QBLK - 1) break; qkt<t>(p0, p1, K_lds, r32, hi, S.qr);                                                                 \
            if constexpr (MODE == 0) { const int kb_ = cur.qpos0 + (t) * KVBLK; if (kb_ + KVBLK - 1 > qlo) mask_causal(p0, p1, qm - kb_); }   \
            if ((t) == 3 && has_next) { SBAR(); q_loads2<MODE>(BS, nxt, S, wid, r32, hi); SBAR(); }                          \
            partialSM(p0, p1, m_reg, mn, al); finishSM(p0, p1, al, l_reg, pa0, pa1, pa2, pa3);                                \
            if (__any(al < 1.f)) { if (hi == 0) al_l[r32] = al; asm volatile("s_waitcnt lgkmcnt(0)" ::: "memory");            \
                for (int d_ = 0; d_ < 4; ++d_) for (int r = 0; r < 16; ++r) o[d_][r] *= al_l[crow(r, hi)]; }                  \
            SBAR(); pv_tile<t>(o, vb0, pa0, pa1, pa2, pa3); } while (0)
        TILE(0); TILE(1); TILE(2); TILE(3);
#undef TILE
    } else if (has_next) { q_loads2<MODE>(BS, nxt, S, wid, r32, hi); }
    mo = m_reg; lo = l_reg;
    if constexpr (MODE == 1) {
        if (active) {
            if (hi == 0) li_l[r32] = l_reg; asm volatile("s_waitcnt lgkmcnt(0)" ::: "memory");
            if (hi == 0 && wid * QBLK + r32 < cur.rows) { const unsigned e = entl[r32]; *(f32x2*)(BS.wsb + (BS.oPML + (((cur.pbase + (e & 4095u)) * 3u + (e >> 12) - 1u) << 3))) = (f32x2){m_reg, l_reg}; }
#pragma unroll
            for (int r = 0; r < 16; ++r) { const int row = crow(r, hi); const float rl = 16.f * __builtin_amdgcn_rcpf(li_l[row]); const unsigned e = entl[row];
                const unsigned pb_ = BS.oPART + ((((cur.pbase + (e & 4095u)) * 3u + (e >> 12) - 1u) << 7) + (unsigned)r32 * 4u);
                const unsigned pk = (unsigned)__builtin_amdgcn_cvt_pk_fp8_f32(o[2][r] * rl, o[3][r] * rl, __builtin_amdgcn_cvt_pk_fp8_f32(o[0][r] * rl, o[1][r] * rl, 0, false), true);
                if (wid * QBLK + row < cur.rows) *(unsigned*)(BS.wsb + pb_) = pk; }
        }
    }
}
__device__ __forceinline__ void own_finish(const Bases& BS, const CRef& cur, char* lds, const int tid, const float m_reg, const float l_reg, const f32x16 (&o)[4],
                                           const CRef& nxt, const unsigned nkoff, const int nkey0, QState& S, KVRegs& R) {
    const int wid = __builtin_amdgcn_readfirstlane(tid >> 6), lane = tid & 63, r32 = lane & 31, hi = lane >> 5;
    float* ws = (float*)(lds + R_WS) + wid * 256; float* li_l = ws; float* wts = ws + 96;
    char* ost = lds + wid * 8192;
    constexpr float C2 = 1.4426950408889634f * SCALE;
    const int ns = cur.ns;
    const int wrow = rb0(wid);
    f32x2 pm[3];
    const unsigned prow = (cur.pbase + (unsigned)(cur.qpos0 + wrow * QBLK + r32)) * 3u;
#pragma unroll
    for (int s2 = 0; s2 < 3; ++s2) pm[s2] = (s2 < ns) ? *(const f32x2*)(BS.wsb + (BS.oPML + ((prow + (unsigned)s2) << 3))) : (f32x2){-1e30f, 0.f};
    unsigned pp[16][3];
#pragma unroll
    for (int r = 0; r < 16; ++r) { const unsigned pro_ = BS.oPART + (((cur.pbase + (unsigned)(cur.qpos0 + wrow * QBLK + crow(r, hi))) * 3u) << 7) + (unsigned)r32 * 4u;
#pragma unroll
        for (int s2 = 0; s2 < 3; ++s2) pp[r][s2] = (s2 < ns) ? *(const unsigned*)(BS.wsb + (pro_ + (unsigned)s2 * 128u)) : 0u; }
    if (hi == 0) li_l[r32] = l_reg;
    if (hi == 0) { const float M = fmaxf(fmaxf(m_reg, pm[0][0]), fmaxf(pm[1][0], pm[2][0]));
        const float w0 = l_reg * __builtin_amdgcn_exp2f((m_reg - M) * C2), w1 = pm[0][1] * __builtin_amdgcn_exp2f((pm[0][0] - M) * C2), w2 = pm[1][1] * __builtin_amdgcn_exp2f((pm[1][0] - M) * C2), w3 = pm[2][1] * __builtin_amdgcn_exp2f((pm[2][0] - M) * C2);
        const float inv = __builtin_amdgcn_rcpf(w0 + w1 + w2 + w3);
        const float inv16 = inv * 0.0625f;
        *(f32x4*)(wts + r32 * 4) = (f32x4){w0 * inv, w1 * inv16, w2 * inv16, w3 * inv16}; }
    asm volatile("s_waitcnt lgkmcnt(0)" ::: "memory");
#pragma unroll
    for (int r = 0; r < 16; ++r) { const int orow = crow(r, hi); const f32x4 wv = *(const f32x4*)(wts + orow * 4); const float w0 = wv[0] * __builtin_amdgcn_rcpf(li_l[orow]);
        float mg[4] = {o[0][r] * w0, o[1][r] * w0, o[2][r] * w0, o[3][r] * w0};
#pragma unroll
        for (int s2 = 0; s2 < 3; ++s2) { const f32x2 p01 = __builtin_amdgcn_cvt_pk_f32_fp8((int)pp[r][s2], false), p23 = __builtin_amdgcn_cvt_pk_f32_fp8((int)pp[r][s2], true); const float wk = wv[s2 + 1];
            mg[0] += p01[0] * wk; mg[1] += p01[1] * wk; mg[2] += p23[0] * wk; mg[3] += p23[1] * wk; }
#pragma unroll
        for (int d0 = 0; d0 < 4; ++d0) { const float v = mg[d0];
            const float vn = __uint_as_float((unsigned)__builtin_amdgcn_update_dpp(0, (int)__float_as_uint(v), 0xB1, 0xF, 0xF, false));
            const unsigned pk = cvt_pk_bf16(v, vn);
            if ((r32 & 1) == 0) *(unsigned*)(ost + (orow * 128 + d0 * 32 + r32) * 2) = pk; } }
    load_kv_issue(BS, nkoff, nkey0, tid, R);
    q_loads2<0>(BS, nxt, S, wrow, r32, hi);
    asm volatile("s_waitcnt lgkmcnt(0)" ::: "memory");
    const unsigned ow_ = BS.oO + cur.qoff + (unsigned)(wrow * QBLK) * LD;
#pragma unroll
    for (int ii = 0; ii < 8; ++ii) { const int row = ii * 4 + (lane >> 4), ch = lane & 15; const u32x4 own = *(const u32x4*)(ost + (row * 128 + ch * 8) * 2);
        u32x2 w8; w8.x = __builtin_amdgcn_cvt_pk_fp8_f32(bf_lo(own.y), bf_hi(own.y), __builtin_amdgcn_cvt_pk_fp8_f32(bf_lo(own.x), bf_hi(own.x), 0u, false), true);
        w8.y = __builtin_amdgcn_cvt_pk_fp8_f32(bf_lo(own.w), bf_hi(own.w), __builtin_amdgcn_cvt_pk_fp8_f32(bf_lo(own.z), bf_hi(own.z), 0u, false), true);
        *(u32x2*)(BS.wsb + (ow_ + (unsigned)row * LD + (unsigned)ch * 8u)) = w8; }
}
#undef LDG8
#undef VMW
#undef VMWN
#undef SLOAD_H
#undef SWRITE_HK
#undef SWRITE_HV
#undef SWRITE_H
#undef SBAR
#undef KSWZ
}

constexpr int NWAVES = 8;
constexpr int N_LAUNCHES = MK_N_LAUNCHES;
constexpr int PER_PHASE = 13;
constexpr size_t MiB = 1u << 20;
constexpr size_t WS_CTL = 0, CTL_ZERO_BYTES = 1 * MiB;
constexpr size_t WS_SGUW = 1 * MiB;
constexpr size_t WS_ROPE = WS_SGUW + 256 * 1024;
constexpr size_t WS_KM = 2 * MiB;
constexpr size_t WS_TOKW = WS_KM + 256 * 1024;
constexpr size_t WS_WR = 3 * MiB;
constexpr size_t WS_LIST = 4 * MiB;
constexpr size_t WS_LISTR = 12 * MiB;
constexpr size_t WS_WIN = 8 * MiB;
constexpr size_t WS_WPA = 44 * MiB, WS_WPB = 48 * MiB, WS_WOUT = 52 * MiB;
constexpr size_t WS_H = 60 * MiB;
constexpr size_t WS_AO = 60 * MiB, WS_GO = 124 * MiB;
constexpr size_t WS_Q = 188 * MiB, WS_K = 252 * MiB, WS_V = 316 * MiB, WS_U = 380 * MiB, WS_VG = 444 * MiB;
constexpr size_t WS_GA = 508 * MiB, WS_GS = 636 * MiB;
constexpr size_t WS_MG = 764 * MiB;
constexpr size_t WS_LOG = 956 * MiB;
constexpr size_t WS_WGU = 976 * MiB;
constexpr size_t WS_WD = 892 * MiB;
constexpr size_t WS_H8 = 380 * MiB;
constexpr size_t WS_HID = 444 * MiB;
constexpr size_t WS_Y = 716 * MiB;
constexpr size_t WS_H1_8 = 892 * MiB;
constexpr size_t WS_WIN8 = 956 * MiB;
constexpr size_t WS_WPA8 = 974 * MiB;
constexpr size_t WS_ALIST = 764 * MiB;
constexpr size_t WS_PML = 772 * MiB;
constexpr size_t WS_PART = 780 * MiB;
constexpr size_t WS_END = 1104 * MiB;
constexpr int CW_TMO = 0, CW_CODE = 1;
constexpr int CW_CNT = 64;
constexpr int CW_WORK = 3072;
constexpr int CW_DONE = 3200;
constexpr int CW_BAR = 4096;
constexpr int CW_ACNT = 49152;
constexpr int CW_SS = 16384;
constexpr int RING_OFF = 0, RING_BYTES = 131072;
constexpr int SCR_BYTES = 8 * 17408;
constexpr int LDSCTL_OFF = 140288, MISC_OFF = LDSCTL_OFF + 320;
static_assert(SCR_BYTES <= LDSCTL_OFF && RING_BYTES + 9 * 256 * 4 <= LDSCTL_OFF, "LDS map");
constexpr int TAB_OFF = LDSCTL_OFF + 1024;
constexpr int TABA_OFF = 145408;
constexpr int LDS_BYTES = 151552;
static_assert(TABA_OFF + 1025 * 4 <= LDS_BYTES && TAB_OFF + (961 + 32) * 4 <= TABA_OFF && att::LDS_BYTES2 <= LDSCTL_OFF && att::R_BYTES <= LDSCTL_OFF, "LDS map");
static_assert(TAB_OFF + 961 * 4 <= LDS_BYTES, "LDS map");

typedef GAS unsigned gu32;
#define RLX_AGENT __ATOMIC_RELAXED, __HIP_MEMORY_SCOPE_AGENT
#define LDS_WAIT() asm volatile("s_waitcnt lgkmcnt(0)" ::: "memory")
#define VM_WAIT() asm volatile("s_waitcnt vmcnt(0)" ::: "memory")

#define XB_TMO      128
#define XB_XCNT(j)  (256  + 64 * (j))
#define XB_XSUB(j)  (1280 + 64 * (j))
#define XB_XGEN(j)  (2304 + 64 * (j))
#define XB_TOP      3328
#define XB_TOPGEN   3392
#define XCD_BAR_WORDS 3456
#define XB_SPIN_CAP (1u << 18)
__device__ __forceinline__ unsigned xb_ld(unsigned* p)              { return __hip_atomic_load(p, __ATOMIC_RELAXED, __HIP_MEMORY_SCOPE_AGENT); }
__device__ __forceinline__ unsigned xb_add(unsigned* p, unsigned v) { return __hip_atomic_fetch_add(p, v, __ATOMIC_RELAXED, __HIP_MEMORY_SCOPE_AGENT); }
__device__ __forceinline__ unsigned xb_xcc_id() { return (unsigned)__builtin_amdgcn_s_getreg((3 << 11) | 20) & 0xFu; }
#define XB_SPIN(cond, bar) do { unsigned _sp = 0; while (cond) { __builtin_amdgcn_s_sleep(1); \
    if ((++_sp & 255u) == 0u) { if (xb_ld(&(bar)[XB_TMO])) break; if (_sp > XB_SPIN_CAP) { atomicAdd(&(bar)[XB_TMO], 1u); break; } } } } while (0)
struct XcdBarrier { unsigned* bar; unsigned x; volatile LAS unsigned* st; };
__device__ __forceinline__ XcdBarrier xcd_barrier_post(unsigned* bar, volatile LAS unsigned* st) {
    XcdBarrier b; b.bar = bar; b.x = xb_xcc_id(); b.st = st;
    if (threadIdx.x == 0) (void)xb_add(&bar[XB_XCNT(b.x)], 1u);
    return b;
}
__device__ __forceinline__ void xcd_barrier_complete(unsigned* bar, unsigned x, unsigned& nloc, unsigned& nx, const unsigned G) {
    unsigned sum, cnt, mine, sp = 0u;
    for (;;) {
        sum = 0u; cnt = 0u; mine = 0u;
#pragma unroll
        for (unsigned j = 0; j < 16; ++j) { const unsigned c = xb_ld(&bar[XB_XCNT(j)]); sum += c; cnt += (c > 0u) ? 1u : 0u; mine = (j == x) ? c : mine; }
        if (sum == G) break;
        __builtin_amdgcn_s_sleep(1);
        if ((++sp & 255u) == 0u) { if (xb_ld(&bar[XB_TMO])) break; if (sp > XB_SPIN_CAP) { atomicAdd(&bar[XB_TMO], 1u); break; } }
    }
    nloc = mine > 0u ? mine : 1u; nx = cnt > 0u ? cnt : 1u;
}
__device__ __forceinline__ void xcd_barrier(const XcdBarrier& b) {
    asm volatile("s_waitcnt vmcnt(0)" ::: "memory");
    __syncthreads();
    if (threadIdx.x == 0) {
        unsigned* bar = b.bar;
        __builtin_amdgcn_s_waitcnt(0);
        unsigned nloc = b.st[0], nx = b.st[1];
        if (nloc == 0u) { xcd_barrier_complete(bar, b.x, nloc, nx, b.st[8]); b.st[0] = nloc; b.st[1] = nx; }
        const unsigned old = xb_add(&bar[XB_XSUB(b.x)], 1u);
        const unsigned gen = old / nloc;
        if (old + 1u == (gen + 1u) * nloc) {
            __builtin_amdgcn_fence(__ATOMIC_RELEASE, "agent");
            asm volatile("s_waitcnt vmcnt(0)" ::: "memory");
            const unsigned og = xb_add(&bar[XB_TOP], 1u);
            const unsigned tg = og / nx;
            if (og + 1u == (tg + 1u) * nx) xb_add(&bar[XB_TOPGEN], 1u);
            else XB_SPIN(xb_ld(&bar[XB_TOPGEN]) == tg, bar);
            __builtin_amdgcn_fence(__ATOMIC_ACQUIRE, "agent");
            xb_add(&bar[XB_XGEN(b.x)], 1u);
            asm volatile("s_waitcnt vmcnt(0)" ::: "memory");
        } else {
            XB_SPIN(xb_ld(&bar[XB_XGEN(b.x)]) == gen, bar);
            __builtin_amdgcn_fence(__ATOMIC_ACQUIRE, "agent");
            asm volatile("s_waitcnt vmcnt(0)" ::: "memory");
        }
    }
    __syncthreads();
}

struct Frame {
    LAS unsigned char* lds;
    volatile LAS unsigned* MISC;
    unsigned* ctl;
    int tid, lane, wave;
    int vcu, G;
    unsigned char* ws;
    float* out;
};

__device__ __forceinline__ float wave_sum(float v) {
#pragma unroll
    for (int o = 1; o < 64; o <<= 1) v += __shfl_xor(v, o);
    return v;
}
__device__ __forceinline__ unsigned f2bf(float f) { unsigned u = __builtin_bit_cast(unsigned, f); return (u + 0x7fffu + ((u >> 16) & 1u)) >> 16; }
__device__ __forceinline__ unsigned pk2(float lo, float hi) { return f2bf(lo) | (f2bf(hi) << 16); }

__device__ __forceinline__ void transpose_item(const float* W, int K, int N, bf16_t* WT, int k0, int n0, int drow0, LAS float* scr, int lane) {
    f32x4 v[8]; const float* src = W + (size_t)(k0 + (lane >> 3)) * N + n0 + 4 * (lane & 7);
#pragma unroll
    for (int i = 0; i < 8; ++i) v[i] = __builtin_nontemporal_load((const f32x4*)(src + (size_t)(8 * i) * N));
#pragma unroll
    for (int i = 0; i < 8; ++i) { LAS float* d = scr + ((lane >> 3) + 8 * i) * 33 + 4 * (lane & 7); d[0] = v[i][0]; d[1] = v[i][1]; d[2] = v[i][2]; d[3] = v[i][3]; }
    LDS_WAIT(); asm volatile("" ::: "memory");
    const int c = lane & 7;
#pragma unroll
    for (int j = 0; j < 4; ++j) { const int n = (lane >> 3) + 8 * j; const LAS float* s = scr + (8 * c) * 33 + n;
        u32x4 o; o.x = pk2(s[0 * 33], s[1 * 33]); o.y = pk2(s[2 * 33], s[3 * 33]); o.z = pk2(s[4 * 33], s[5 * 33]); o.w = pk2(s[6 * 33], s[7 * 33]);
        *(u32x4*)(WT + (size_t)(drow0 + n) * K + k0 + 8 * c) = o; }
    LDS_WAIT(); asm volatile("" ::: "memory");
}
__device__ __forceinline__ unsigned pk4_fp8(float a, float b, float c, float d) { unsigned w = __builtin_amdgcn_cvt_pk_fp8_f32(a, b, 0u, false); return __builtin_amdgcn_cvt_pk_fp8_f32(c, d, w, true); }
__device__ __forceinline__ void t8_issue(const float* W, int N, int k0, int n0, int lane, f32x4 (&v)[16]) {
    const float* src = W + (size_t)(k0 + 16 * (lane >> 3)) * N + n0 + 4 * (lane & 7);
#pragma unroll
    for (int i = 0; i < 16; ++i) v[i] = __builtin_nontemporal_load((const f32x4*)(src + (size_t)i * N));
}
__device__ __forceinline__ void t8_store(const f32x4 (&v)[16], unsigned char* WT, int K, int k0, int drow0, int lane, float scale) {
    unsigned char* dst = WT + (size_t)(drow0 + 4 * (lane & 7)) * K + k0 + 16 * (lane >> 3);
#pragma unroll
    for (int j = 0; j < 4; ++j) { u32x4 o;
        o.x = pk4_fp8(v[0][j] * scale, v[1][j] * scale, v[2][j] * scale, v[3][j] * scale); o.y = pk4_fp8(v[4][j] * scale, v[5][j] * scale, v[6][j] * scale, v[7][j] * scale);
        o.z = pk4_fp8(v[8][j] * scale, v[9][j] * scale, v[10][j] * scale, v[11][j] * scale); o.w = pk4_fp8(v[12][j] * scale, v[13][j] * scale, v[14][j] * scale, v[15][j] * scale);
        *(u32x4*)(dst + (size_t)j * K) = o; }
}
__device__ __forceinline__ void transpose_item8(const float* W, int K, int N, unsigned char* WT, int k0, int n0, int drow0, LAS float* scr, int lane, float scale) {
    (void)scr; f32x4 v[16]; t8_issue(W, N, k0, n0, lane, v); t8_store(v, WT, K, k0, drow0, lane, scale);
}
__device__ __forceinline__ int claim_async(unsigned* ctr, unsigned n) { int ret; asm volatile("global_atomic_add %0, %1, %2, off sc0" : "=v"(ret) : "v"(ctr), "v"(n) : "memory"); return ret; }
struct ConvItem { const float* W; unsigned char* WT; int K, N, k0, n0, drow0; };
__device__ __forceinline__ ConvItem conv_decode(int it, __attribute__((address_space(4))) const char* kp, unsigned char* ws) {
    constexpr int IGU = NE * 2 * (DM / 128) * (FF / 32);
    ConvItem c; int sel; size_t so, dof;
    if (it < IGU) { const int e = it >> 10, r = it & 1023, which = r >> 9, q = r & 511, kb = q >> 5, nb = q & 31, n0 = 32 * nb;
        sel = which; so = (size_t)e * DM * FF; c.K = DM; c.N = FF; dof = WS_WGU + (size_t)e * DM * DM; c.k0 = 128 * kb; c.n0 = n0; c.drow0 = (n0 >> 7) * 256 + which * 128 + (n0 & 127); }
    else { const int j = it - IGU, e = j >> 9, q = j & 511, kb = q >> 6, nb = q & 63;
        sel = 2; so = (size_t)e * FF * DM; c.K = FF; c.N = DM; dof = WS_WD + (size_t)e * DM * FF; c.k0 = 128 * kb; c.n0 = 32 * nb; c.drow0 = 32 * nb; }
    const float* wsrc = (const float*)(GAS const float*)(*(const __attribute__((address_space(4))) unsigned long long*)(kp + 8 * (15 + sel)));
    c.W = wsrc + so; c.WT = ws + dof;
    return c;
}
__device__ __forceinline__ void conv_issue(const ConvItem& c, int lane, f32x4 (&v)[16]) { t8_issue(c.W, c.N, c.k0, c.n0, lane, v); }
__device__ __forceinline__ void conv_process(const ConvItem& cc, const f32x4 (&v)[16], LAS float* scr, int lane, float scale) { (void)scr; t8_store(v, cc.WT, cc.K, cc.k0, cc.drow0, lane, scale); }
__device__ __forceinline__ void transpose_matrix(Frame& F, const float* W, int K, int N, bf16_t* WT, LAS float* scr) {
    const int gw = F.vcu * NWAVES + F.wave, NGW = F.G * NWAVES; const int nblk = N / 32, items = (K / 64) * nblk;
    for (int it = gw; it < items; it += NGW) { const int kb = it / nblk, nb = it % nblk; transpose_item(W, K, N, WT, 64 * kb, 32 * nb, 32 * nb, scr, F.lane); }
}
__device__ __forceinline__ void rms_row_to_bf16(Frame& F, const float* xrow, const float* gain, bf16_t* orow, unsigned* orow8 = nullptr) {
    const f32x4* xr = (const f32x4*)xrow + F.lane; const f32x4* gr = (const f32x4*)gain + F.lane;
    f32x4 v[8]; float s = 0.f;
#pragma unroll
    for (int j = 0; j < 8; ++j) { v[j] = __builtin_nontemporal_load(xr + 64 * j); s += (v[j].x * v[j].x + v[j].y * v[j].y) + (v[j].z * v[j].z + v[j].w * v[j].w); }
    const float rstd = 1.0f / sqrtf(wave_sum(s) * (1.f / DM) + EPS);
    u32x2* o8 = (u32x2*)orow + F.lane;
#pragma unroll
    for (int j = 0; j < 8; ++j) { const f32x4 g = gr[64 * j]; const float y0 = v[j].x * rstd * g.x, y1 = v[j].y * rstd * g.y, y2 = v[j].z * rstd * g.z, y3 = v[j].w * rstd * g.w;
        u32x2 w; w.x = pk2(y0, y1); w.y = pk2(y2, y3); o8[64 * j] = w; if (orow8) orow8[64 * j + F.lane] = pk4_fp8(y0, y1, y2, y3); }
}

struct EpiProj {
    static constexpr bool PERM = true;
    unsigned char* ws; const f32x4* rope; int pn_base;
    __device__ __forceinline__ void operator()(const f32x4 (&acc)[2][2][4][2], const pg8::Unit& u, int wr, int wc, int fr, int fq) const {
#ifdef PROBE_SKIP_EPI
        if (u.x2) return;
#endif
        const int pn = u.pn + pn_base; int mode, ldc, colt; size_t boff;
        if (pn < 20) { const int t = pn >> 2; ldc = 1024; colt = (pn & 3) * 256; boff = WS_Q + (size_t)t * (64 * MiB); mode = (t < 2) ? 1 : (t == 2 ? 0 : 2); }
        else { const int t = (pn - 20) >> 3; ldc = 2048; colt = ((pn - 20) & 7) * 256; boff = WS_GA + (size_t)t * (128 * MiB); mode = 3; }
        bf16_t* base = (bf16_t*)(ws + boff);
        const int row0 = u.pm * 256 + wr * 64 + fr, col0 = colt + wc * 32 + 8 * fq;
        const bool do_rope = (mode == 1) && (wc == 0);
#pragma unroll
        for (int ai = 0; ai < 2; ++ai) {
            f32x4 cs[4][4];
#pragma unroll
            for (int m = 0; m < 4; ++m) { const int row = row0 + ai * 128 + m * 16; const f32x4* rp = rope + (do_rope ? ((size_t)(row & (SEQ - 1)) * 16 + 8 * (fq & 1)) / 2 : (size_t)0);
#pragma unroll
                for (int q = 0; q < 4; ++q) cs[m][q] = rp[q]; }
#pragma unroll
            for (int m = 0; m < 4; ++m) { const int row = row0 + ai * 128 + m * 16; bf16_t* rowp = base + (size_t)row * ldc + col0;
#pragma unroll
                for (int bj = 0; bj < 2; ++bj) { f32x4 v0 = acc[ai][bj][m][0], v1 = acc[ai][bj][m][1];
                    if (do_rope) {
                        float x[8] = {v0[0], v0[1], v0[2], v0[3], v1[0], v1[1], v1[2], v1[3]};
#pragma unroll
                        for (int e = 0; e < 8; ++e) { const auto sw_ = __builtin_amdgcn_permlane32_swap(__float_as_uint(x[e]), __float_as_uint(x[e]), false, false);
                            const float p = __uint_as_float(fq < 2 ? sw_[1] : sw_[0]); const float c = cs[m][e >> 1][(e & 1) * 2], sn = cs[m][e >> 1][(e & 1) * 2 + 1];
                            x[e] = (fq < 2) ? (x[e] * c - p * sn) : (x[e] * c + p * sn); }
                        v0 = (f32x4){x[0], x[1], x[2], x[3]}; v1 = (f32x4){x[4], x[5], x[6], x[7]};
                    } else if (mode == 2) {
#pragma unroll
                        for (int e = 0; e < 4; ++e) { v0[e] = gelu_tanh_f(v0[e]); v1[e] = gelu_tanh_f(v1[e]); }
                    } else if (mode == 3) {
#pragma unroll
                        for (int e = 0; e < 4; ++e) { v0[e] = sigmoid_f(v0[e]); v1[e] = sigmoid_f(v1[e]); }
                    }
                    u32x4 w; w.x = cvt_pk_bf16(v0[0], v0[1]); w.y = cvt_pk_bf16(v0[2], v0[3]); w.z = cvt_pk_bf16(v1[0], v1[1]); w.w = cvt_pk_bf16(v1[2], v1[3]);
                    __builtin_nontemporal_store(w, (u32x4*)(rowp + bj * 128)); } }
#pragma unroll
            for (int m = 0; m < 4; ++m) asm volatile("" :: "v"(cs[m][0]), "v"(cs[m][1]), "v"(cs[m][2]), "v"(cs[m][3]));
        }
    }
};
template <bool ADD> struct EpiGate {
    static constexpr bool PERM = true;
    const bf16_t* gate; bf16_t* out;
    __device__ __forceinline__ void operator()(const f32x4 (&acc)[2][2][4][2], const pg8::Unit& u, int wr, int wc, int fr, int fq) const {
        const int row0 = u.pm * 256 + wr * 64 + fr, col0 = u.pn * 256 + wc * 32 + 8 * fq;
#pragma unroll
        for (int ai = 0; ai < 2; ++ai) {
            u32x4 g[4][2], p[4][2];
#pragma unroll
            for (int m = 0; m < 4; ++m) { const size_t off = (size_t)(row0 + ai * 128 + m * 16) * DM + col0;
#pragma unroll
                for (int bj = 0; bj < 2; ++bj) { g[m][bj] = __builtin_nontemporal_load((const u32x4*)(gate + off + bj * 128));
                    if (ADD) p[m][bj] = *(const u32x4*)(out + off + bj * 128); } }
#pragma unroll
            for (int m = 0; m < 4; ++m) { const size_t off = (size_t)(row0 + ai * 128 + m * 16) * DM + col0;
#pragma unroll
                for (int bj = 0; bj < 2; ++bj) { const f32x4 v0 = acc[ai][bj][m][0], v1 = acc[ai][bj][m][1]; const u32x4 gg = g[m][bj];
                    float r[8] = {v0[0] * bf_lo(gg.x), v0[1] * bf_hi(gg.x), v0[2] * bf_lo(gg.y), v0[3] * bf_hi(gg.y), v1[0] * bf_lo(gg.z), v1[1] * bf_hi(gg.z), v1[2] * bf_lo(gg.w), v1[3] * bf_hi(gg.w)};
                    if (ADD) { const u32x4 pp = p[m][bj];
                        r[0] += bf_lo(pp.x); r[1] += bf_hi(pp.x); r[2] += bf_lo(pp.y); r[3] += bf_hi(pp.y); r[4] += bf_lo(pp.z); r[5] += bf_hi(pp.z); r[6] += bf_lo(pp.w); r[7] += bf_hi(pp.w); }
                    u32x4 w; w.x = cvt_pk_bf16(r[0], r[1]); w.y = cvt_pk_bf16(r[2], r[3]); w.z = cvt_pk_bf16(r[4], r[5]); w.w = cvt_pk_bf16(r[6], r[7]);
                    if constexpr (ADD) __builtin_nontemporal_store(w, (u32x4*)(out + off + bj * 128)); else *(u32x4*)(out + off + bj * 128) = w; } }
        }
    }
};
struct EpiResNorm {
    static constexpr bool PERM = true;
    const float* x; const float* g; bf16_t* h2u; unsigned char* h2u8; float* ss;
    __device__ __forceinline__ void operator()(const f32x4 (&acc)[2][2][4][2], const pg8::Unit& u, int wr, int wc, int fr, int fq) const {
        const int row0 = u.pm * 256 + wr * 64 + fr, col0 = u.pn * 256 + wc * 32 + 8 * fq;
        f32x4 gv[2][2];
#pragma unroll
        for (int bj = 0; bj < 2; ++bj) { gv[bj][0] = *(const f32x4*)(g + col0 + bj * 128); gv[bj][1] = *(const f32x4*)(g + col0 + bj * 128 + 4); }
#pragma unroll
        for (int ai = 0; ai < 2; ++ai)
#pragma unroll
            for (int mp = 0; mp < 2; ++mp) {
                f32x4 xv[2][2][2];
#pragma unroll
                for (int mm = 0; mm < 2; ++mm) { const size_t off = (size_t)(row0 + ai * 128 + (mp * 2 + mm) * 16) * DM + col0;
#pragma unroll
                    for (int bj = 0; bj < 2; ++bj) { xv[mm][bj][0] = *(const f32x4*)(x + off + bj * 128); xv[mm][bj][1] = *(const f32x4*)(x + off + bj * 128 + 4); } }
#pragma unroll
                for (int mm = 0; mm < 2; ++mm) { const int m = mp * 2 + mm; const int row = row0 + ai * 128 + m * 16; const size_t off = (size_t)row * DM + col0; float sq = 0.f;
#pragma unroll
                    for (int bj = 0; bj < 2; ++bj) { const f32x4 v0 = xv[mm][bj][0] + acc[ai][bj][m][0], v1 = xv[mm][bj][1] + acc[ai][bj][m][1];
                        sq += (v0[0] * v0[0] + v0[1] * v0[1]) + (v0[2] * v0[2] + v0[3] * v0[3]) + (v1[0] * v1[0] + v1[1] * v1[1]) + (v1[2] * v1[2] + v1[3] * v1[3]);
                        const f32x4 h0 = v0 * gv[bj][0], h1 = v1 * gv[bj][1];
                        u32x4 w; w.x = cvt_pk_bf16(h0[0], h0[1]); w.y = cvt_pk_bf16(h0[2], h0[3]); w.z = cvt_pk_bf16(h1[0], h1[1]); w.w = cvt_pk_bf16(h1[2], h1[3]);
                        *(u32x4*)(h2u + off + bj * 128) = w;
                        u32x2 w8; w8.x = pk4_fp8(h0[0], h0[1], h0[2], h0[3]); w8.y = pk4_fp8(h1[0], h1[1], h1[2], h1[3]);
                        *(u32x2*)(h2u8 + off + bj * 128) = w8; }
                    sq += __shfl_xor(sq, 16); sq += __shfl_xor(sq, 32);
                    if (fq == 0 && !u.x2) (void)__hip_atomic_fetch_add(ss + row, sq, __ATOMIC_RELAXED, __HIP_MEMORY_SCOPE_AGENT); }
            }
    }
};
struct EpiLogits {
    static constexpr bool PERM = false;
    float* out;
    __device__ __forceinline__ void operator()(const f32x4 (&acc)[2][2][4][2], const pg8::Unit& u, int wr, int wc, int fr, int fq) const {
        if (wc >= 2) return;
        const int row0 = u.pm * 256 + wr * 64 + fr, col0 = wc * 32 + 4 * fq;
#pragma unroll
        for (int ai = 0; ai < 2; ++ai)
#pragma unroll
            for (int m = 0; m < 4; ++m) { float* rowp = out + (size_t)(row0 + ai * 128 + m * 16) * 64 + col0;
#pragma unroll
                for (int n = 0; n < 2; ++n) *(f32x4*)(rowp + n * 16) = acc[ai][0][m][n]; }
    }
};
struct EpiSwiglu {
    static constexpr bool PERM = true;
    unsigned char* hid; const float* listr;
    __device__ __forceinline__ void operator()(const f32x4 (&acc)[2][2][4][2], const pg8::Unit& u, int wr, int wc, int fr, int fq) const {
        const int row0 = u.pm * 256 + wr * 64 + fr, col0 = u.pn * 128 + wc * 32 + 8 * fq, r0 = wr * 64 + fr;
        float rs[2][4];
#pragma unroll
        for (int ai = 0; ai < 2; ++ai)
#pragma unroll
            for (int m = 0; m < 4; ++m) { const int r = r0 + ai * 128 + m * 16; rs[ai][m] = listr[u.x0 + (r < u.x1 ? r : 0)]; }
#pragma unroll
        for (int ai = 0; ai < 2; ++ai) {
#pragma unroll
            for (int m = 0; m < 4; ++m) { unsigned char* rowp = hid + (size_t)(row0 + ai * 128 + m * 16) * FF + col0;
                const float rstd = rs[ai][m];
                const f32x4 g0 = acc[ai][0][m][0] * rstd, g1 = acc[ai][0][m][1] * rstd, u0 = acc[ai][1][m][0] * rstd, u1 = acc[ai][1][m][1] * rstd;
                float r[8];
#pragma unroll
                for (int e = 0; e < 4; ++e) { r[e] = silu_f(g0[e]) * u0[e]; r[4 + e] = silu_f(g1[e]) * u1[e]; }
                u32x2 w; w.x = pk4_fp8(r[0], r[1], r[2], r[3]); w.y = pk4_fp8(r[4], r[5], r[6], r[7]);
                *(u32x2*)rowp = w; }
        }
    }
};
struct EpiScatter {
    static constexpr bool PERM = true;
    const int* list; unsigned char* Y;
    __device__ __forceinline__ void operator()(const f32x4 (&acc)[2][2][4][2], const pg8::Unit& u, int wr, int wc, int fr, int fq) const {
        const int r0 = wr * 64 + fr, col0 = u.pn * 256 + wc * 32 + 8 * fq;
        int aid[2][4];
#pragma unroll
        for (int ai = 0; ai < 2; ++ai)
#pragma unroll
            for (int m = 0; m < 4; ++m) { const int r = r0 + ai * 128 + m * 16; aid[ai][m] = list[u.x0 + (r < u.x1 ? r : 0)]; }
#pragma unroll
        for (int ai = 0; ai < 2; ++ai)
#pragma unroll
            for (int m = 0; m < 4; ++m) { const int r = r0 + ai * 128 + m * 16;
                if (r < u.x1) { unsigned char* rowp = Y + (size_t)aid[ai][m] * DM + col0;
#pragma unroll
                    for (int bj = 0; bj < 2; ++bj) { const f32x4 v0 = acc[ai][bj][m][0], v1 = acc[ai][bj][m][1];
                        u32x2 w; w.x = pk4_fp8(v0[0], v0[1], v0[2], v0[3]); w.y = pk4_fp8(v1[0], v1[1], v1[2], v1[3]);
                        *(u32x2*)(rowp + bj * 128) = w; } } }
        asm volatile("" :: "v"(aid[0][0]), "v"(aid[0][1]), "v"(aid[0][2]), "v"(aid[0][3]), "v"(aid[1][0]), "v"(aid[1][1]), "v"(aid[1][2]), "v"(aid[1][3]));
    }
};

template <bool GATHER_> struct MoeOrder {
    static constexpr bool GATHER = GATHER_;
    const LAS int* tab; int nrb, G, vcu; const char* A; const char* Bt; size_t a_rb_bytes, b_e_bytes, b_pn_bytes; const int* list;
    __device__ __forceinline__ bool next(int i, pg8::Unit& u) const {
        int Lv = i * G + vcu; const int slots = ((nrb + 3) >> 2) << 5; if (Lv >= slots * REP_MOE) return false; Lv %= slots;
        const int rb = (Lv >> 5) * 4 + ((Lv & 31) >> 3), pn = Lv & 7;
        const int rbc = rb < nrb ? rb : nrb - 1;
        const int e = __builtin_amdgcn_readfirstlane(tab[rbc]); u.pm = rbc; u.pn = pn; u.x0 = __builtin_amdgcn_readfirstlane(tab[320 + rbc]); u.x1 = __builtin_amdgcn_readfirstlane(tab[640 + rbc]); u.x2 = e;
        u.A = GATHER_ ? A : A + (size_t)rbc * a_rb_bytes; u.B = Bt + (size_t)e * b_e_bytes + (size_t)pn * b_pn_bytes; return true;
    }
    const LAS unsigned* rowtab;
    __device__ __forceinline__ unsigned row_off(const pg8::Unit&, int idx, int r) const { return rowtab[idx * 256 + r]; }
};

struct Args { const float* in[19]; float* out; unsigned char* ws; int ph_lo, ph_hi, li, pad; };
static_assert(offsetof(Args, out) == 152 && offsetof(Args, ws) == 160, "kernarg offsets used by KARG_PTR");

__global__ void __launch_bounds__(NWAVES * 64, 2) fwd_kernel(Args args) {
    extern __shared__ __attribute__((aligned(16))) unsigned char lds[];
    { const int t0_ = threadIdx.x; for (int u = t0_; u < (LDS_BYTES - LDSCTL_OFF) / 4; u += NWAVES * 64) ((LAS unsigned*)((LAS unsigned char*)lds + LDSCTL_OFF))[u] = 0u; }
    __syncthreads();
    if (threadIdx.x == 0) ((LAS unsigned*)((LAS unsigned char*)lds + MISC_OFF))[16] = gridDim.x;
    __syncthreads();
    unsigned* const ctl0 = (unsigned*)(args.ws + WS_CTL);
    XcdBarrier bar; bar.bar = ctl0 + CW_BAR; bar.x = 0; bar.st = nullptr;
    if (N_LAUNCHES != PER_PHASE) bar = xcd_barrier_post(ctl0 + CW_BAR + args.li * XCD_BAR_WORDS, (volatile LAS unsigned*)((LAS unsigned char*)lds + MISC_OFF) + 8);
#define GRID_BAR() do { if (N_LAUNCHES == PER_PHASE) { if (threadIdx.x == 0) __hip_atomic_store((unsigned*)(args.ws + WS_CTL) + CW_TMO, 0xBADBA0u, RLX_AGENT); } else { xcd_barrier(bar); } } while (0)
    const int lo = (N_LAUNCHES == 1) ? 0 : args.ph_lo, hi = (N_LAUNCHES == 1) ? PER_PHASE : args.ph_hi;
#ifndef PH_MASK
#define PH_MASK 0xFFFF
#endif
#define IN(k) ((((PH_MASK) >> (k)) & 1) && lo <= (k) && (k) < hi)
#define BOTH(k) (IN(k) && IN((k) + 1))
    typedef __attribute__((address_space(4))) const char* kptr_t;
#define KARG_PTR(T_, off_) ((T_*)(GAS T_*)(*(const __attribute__((address_space(4))) unsigned long long*)(kp_ + (off_))))
#define KARG_IN(k) KARG_PTR(const float, 8 * (k))
#define PH_CTX() \
    int tid_ = threadIdx.x; asm volatile("" : "+v"(tid_)); \
    int bx_ = blockIdx.x, G_ = __builtin_amdgcn_readfirstlane((int)((volatile LAS unsigned*)((LAS unsigned char*)lds + MISC_OFF))[16]); asm volatile("" : "+s"(bx_), "+s"(G_)); \
    kptr_t kp_ = (kptr_t)__builtin_amdgcn_kernarg_segment_ptr(); asm volatile("" : "+s"(kp_)); unsigned char* ws = KARG_PTR(unsigned char, 160); \
    Frame F; F.lds = (LAS unsigned char*)lds; F.MISC = (volatile LAS unsigned*)(F.lds + MISC_OFF); F.tid = tid_; F.lane = tid_ & 63; F.wave = __builtin_amdgcn_readfirstlane(tid_ >> 6); \
    F.G = G_; F.vcu = (G_ % 8 == 0) ? (bx_ % 8) * (G_ / 8) + bx_ / 8 : bx_; F.ws = ws; F.ctl = (unsigned*)(ws + WS_CTL); F.out = KARG_PTR(float, 152); \
    bf16_t* const H = (bf16_t*)(ws + WS_H); const int gw = F.vcu * NWAVES + F.wave, NGW = F.G * NWAVES; (void)H; (void)gw; (void)NGW

#define CONV_LOOP(POLL_, NA_, CH_) do { \
        int tc_ = threadIdx.x; asm volatile("" : "+v"(tc_)); const int lanec_ = tc_ & 63, wavec_ = __builtin_amdgcn_readfirstlane(tc_ >> 6); \
        LAS float* scr_ = nullptr;     \
        kptr_t kp_ = (kptr_t)__builtin_amdgcn_kernarg_segment_ptr(); asm volatile("" : "+s"(kp_)); unsigned char* ws = KARG_PTR(unsigned char, 160);     \
        constexpr int ITOT_ = NE * 2 * (DM / 128) * (FF / 32) + NE * (FF / 128) * (DM / 32);     \
        unsigned* poll_ = (POLL_); \
          \
          \
          \
        volatile LAS int* cl_ = (volatile LAS int*)(F.lds + MISC_OFF + 128); \
        int nb_ = 0, nd_ = 0; \
        if (tc_ == 0) { cl_[0] = (int)__hip_atomic_fetch_add(F.ctl + CW_WORK, 16u, __ATOMIC_RELAXED, __HIP_MEMORY_SCOPE_AGENT); cl_[2] = poll_ ? (int)__hip_atomic_load(poll_, RLX_AGENT) : 0; } \
        __syncthreads(); \
        for (int r_ = 0;; r_ ^= 1) { \
            const int base_ = __builtin_amdgcn_readfirstlane(cl_[r_]), dn_ = __builtin_amdgcn_readfirstlane(cl_[2 + r_]); \
            if (base_ >= ITOT_) break; \
            const bool stop_ = poll_ && dn_ >= (NA_); \
            if (!stop_ && tc_ == 0) { nb_ = claim_async(F.ctl + CW_WORK, 16u); if (poll_) nd_ = (int)__hip_atomic_load(poll_, RLX_AGENT); } \
            const int it_ = base_ + 2 * wavec_; \
            if (it_ < ITOT_) { f32x4 va_[16], vb_[16]; \
              const ConvItem ca_ = conv_decode(it_, kp_, ws); \
              t8_issue(ca_.W, ca_.N, ca_.k0, ca_.n0, lanec_, va_); t8_issue(ca_.W, ca_.N, ca_.k0, ca_.n0 + 32, lanec_, vb_); \
              t8_store(va_, ca_.WT, ca_.K, ca_.k0, ca_.drow0, lanec_, 32.0f); t8_store(vb_, ca_.WT, ca_.K, ca_.k0, ca_.drow0 + 32, lanec_, 32.0f); \
              asm volatile("" : "+v"(nb_) : "v"(va_[15]), "v"(vb_[15])); }     \
            else if (!stop_ && tc_ == 0) asm volatile("s_waitcnt vmcnt(0)" ::: "memory"); \
            if (stop_) break; \
            if (tc_ == 0) { cl_[r_ ^ 1] = nb_; cl_[2 + (r_ ^ 1)] = nd_; } \
            asm volatile("s_waitcnt lgkmcnt(0)" ::: "memory"); __builtin_amdgcn_s_barrier(); \
        } (void)scr_; } while (0)
#define ROLE_CTX() const bool split_ = (F.G == 320); const bool conv_ = split_ && (F.vcu % 5 == 4); const int na_ = split_ ? 256 : F.G, av_ = split_ ? F.vcu - F.vcu / 5 : F.vcu
#define ROLE_CTX38() const bool split_ = (F.G == 256); const bool conv_ = split_ && ((F.vcu & 7) >= 5); const int na_ = split_ ? 160 : F.G, av_ = split_ ? (F.vcu >> 3) * 5 + (F.vcu & 7) : F.vcu
#define ROLE_DONE(k_) do { __syncthreads(); if (threadIdx.x == 0) (void)__hip_atomic_fetch_add(F.ctl + CW_DONE + 64 * (k_), 1u, __ATOMIC_RELAXED, __HIP_MEMORY_SCOPE_AGENT); } while (0)

    if (IN(0)) {
        PH_CTX();
        for (int rep0_ = 0; rep0_ < REP_P0; ++rep0_) {
        LAS float* scr = (LAS float*)(F.lds + RING_OFF + F.wave * 17408);
        { const int nblk = 1024 / 32, items = (DM / 64) * nblk;
          for (int it = gw; it < items; it += NGW) { const int kb = it / nblk, nb = it % nblk; transpose_item(KARG_IN(2), DM, NPROJ, (bf16_t*)(ws + WS_WIN), 64 * kb, 3072 + 32 * nb, 32 * nb, scr, F.lane); } }
        { LAS float* scr8 = scr;
          constexpr int I1 = (DM / 128) * (NPROJ / 32), I2 = (DA / 128) * (DM / 32);
          for (int it = gw; it < I1 + I2; it += NGW) {
              if (it < I1) { const int kb = it / (NPROJ / 32), nb = it % (NPROJ / 32); transpose_item8(KARG_IN(2), DM, NPROJ, ws + WS_WIN8, 128 * kb, 32 * nb, 32 * nb, scr8, F.lane, 32.0f); }
              else { const int q = it - I1, kb = q / (DM / 32), nb = q % (DM / 32); transpose_item8(KARG_IN(7), DA, DM, ws + WS_WPA8, 128 * kb, 32 * nb, 32 * nb, scr8, F.lane, 32.0f); } } }
        transpose_matrix(F, KARG_IN(8), DS, DM, (bf16_t*)(ws + WS_WPB), scr);
        transpose_matrix(F, KARG_IN(9), DM, DM, (bf16_t*)(ws + WS_WOUT), scr);
        const int gt = F.vcu * (NWAVES * 64) + F.tid, NGT = F.G * NWAVES * 64;
        { bf16_t* WR = (bf16_t*)(ws + WS_WR); const float* wrg = KARG_IN(11); const float* wre = KARG_IN(13);
          for (int i = gt; i < 256 * DM; i += NGT) { const int j = i / DM, k = i % DM; float v = 0.f; if (j < 4) v = wrg[k * 4 + j]; else if (j < 36) v = wre[k * 32 + (j - 4)]; WR[i] = (bf16_t)f2bf(v); } }
        { bf16_t* SW = (bf16_t*)(ws + WS_SGUW); const float* sw = KARG_IN(3);
          for (int i = gt; i < SGU_G * 128 * 128; i += NGT) { const int t = (i >> 7) & 127, s = i & 127; SW[i] = (bf16_t)f2bf(s <= t ? sw[i] : 0.f); } }
        { float* RT = (float*)(ws + WS_ROPE);
          for (int i = gt; i < SEQ * 16; i += NGT) { const int pos = i >> 4, j = i & 15; const float inv = powf(500000.0f, -(float)j / 16.0f); const float ang = (float)pos * inv; RT[2 * i] = cosf(ang); RT[2 * i + 1] = sinf(ang); } }
        for (int m = gw; m < T; m += NGW) rms_row_to_bf16(F, KARG_IN(0) + (size_t)m * DM, KARG_IN(1), H + (size_t)m * DM, (unsigned*)(ws + WS_H1_8 + (size_t)m * DM));
        }
        if (BOTH(0)) GRID_BAR();
    }
    if (IN(1)) {
        PH_CTX();
        {
            pg8::DenseOrder S; S.init(ws + WS_H1_8, ws + WS_WIN8, T, 256 * 32, DM / 2, F.G, bx_, ((REP_GEMM >> 1) & 1) + 1, 12, 4);
            EpiProj E{ws, (const f32x4*)(ws + WS_ROPE), 0};
            pg8::gemm_phase<EpiProj, pg8::DenseOrder, true, true, true>(F.lds + RING_OFF, DM / 2, S, E, F.tid);
        }
        {
            pg8::DenseOrder S; S.init(H, ws + WS_WIN, T, 256 * 4, DM, F.G, bx_, ((REP_GEMM >> 1) & 1) + 1);
            EpiProj E{ws, (const f32x4*)(ws + WS_ROPE), 12};
            pg8::gemm_phase<EpiProj, pg8::DenseOrder, true, true>(F.lds + RING_OFF, DM, S, E, F.tid);
        }
        if (BOTH(1)) GRID_BAR();
    }
    if (IN(2)) {
        PH_CTX();
        const bf16_t* Kb = (const bf16_t*)(ws + WS_K); bf16_t* KM = (bf16_t*)(ws + WS_KM);
        LAS float* red = (LAS float*)(F.lds + RING_OFF);
        for (int it = F.vcu; it < BATCH * NBLK * NH; it += F.G) {
            const int h = it & 7, bb = it >> 3;
            const int cc = F.tid & 15, rg = F.tid >> 4;
            float s[8] = {0.f, 0.f, 0.f, 0.f, 0.f, 0.f, 0.f, 0.f};
            const bf16_t* src = Kb + ((size_t)bb * 256 + rg) * 1024 + h * 128 + cc * 8;
#pragma unroll
            for (int j = 0; j < 8; ++j) { const u32x4 v = *(const u32x4*)(src + (size_t)j * 32 * 1024);
                s[0] += bf_lo(v.x); s[1] += bf_hi(v.x); s[2] += bf_lo(v.y); s[3] += bf_hi(v.y); s[4] += bf_lo(v.z); s[5] += bf_hi(v.z); s[6] += bf_lo(v.w); s[7] += bf_hi(v.w); }
#pragma unroll
            for (int e = 0; e < 8; ++e) red[rg * 128 + cc * 8 + e] = s[e];
            __syncthreads();
            if (F.tid < 128) { float a = 0.f;
#pragma unroll 8
                for (int r = 0; r < 32; ++r) a += red[r * 128 + F.tid];
                KM[(size_t)bb * 1024 + h * 128 + F.tid] = (bf16_t)f2bf(a * (1.0f / 256.0f)); }
            __syncthreads();
        }
        if (BOTH(2)) GRID_BAR();
    }
    if (IN(3)) {
        PH_CTX();
        att::Bases BS; BS.wsb = ws; BS.oQ = (unsigned)WS_Q; BS.oK = (unsigned)WS_K; BS.oV = (unsigned)WS_V; BS.oO = (unsigned)WS_AO; BS.oPART = (unsigned)WS_PART; BS.oPML = (unsigned)WS_PML; BS.oALIST = (unsigned)WS_ALIST;
        unsigned* ACNT = F.ctl + CW_ACNT;
        {
            LAS unsigned* lcnt = (LAS unsigned*)(F.lds + RING_OFF);
            const bf16_t* KM = (const bf16_t*)(ws + WS_KM); unsigned short* AL = (unsigned short*)(ws + WS_ALIST);
            int tS = threadIdx.x; asm volatile("" : "+v"(tS)); const int laneS = tS & 63, r32 = laneS & 31, hi = laneS >> 5, waveS = __builtin_amdgcn_readfirstlane(tS >> 6);
            for (int it = F.vcu; it < BATCH * NH * 15; it += F.G) {
                const int bh = it / 15, bq = it % 15 + 1, b = bh >> 3, h = bh & 7;
                if (tS < 32) lcnt[tS] = 0u;
                __syncthreads();
                const bf16_t* qb = (const bf16_t*)(ws + WS_Q) + ((size_t)(b * SEQ + bq * 256) * 1024 + h * 128); const unsigned ql = (unsigned)((waveS * 32 + r32) * 1024 + hi * 8) * 2u;
                bf16x8 qr[8];
#pragma unroll
                for (int d0 = 0; d0 < 8; ++d0) qr[d0] = *(const bf16x8*)((const char*)qb + (ql + d0 * 32));
                unsigned m = att::moba_select(qr, KM + ((size_t)b * NBLK * 1024 + h * 128), bq, r32, hi);
                int j0 = -1, j1 = -1, j2 = -1; unsigned k0 = 0, k1 = 0, k2 = 0;
                if (hi == 0) {
                    if (m) { j0 = __builtin_ctz(m); m &= m - 1; k0 = __hip_atomic_fetch_add(lcnt + j0, 1u, __ATOMIC_RELAXED, __HIP_MEMORY_SCOPE_WORKGROUP); }
                    if (m) { j1 = __builtin_ctz(m); m &= m - 1; k1 = __hip_atomic_fetch_add(lcnt + j1, 1u, __ATOMIC_RELAXED, __HIP_MEMORY_SCOPE_WORKGROUP); }
                    if (m) { j2 = __builtin_ctz(m); k2 = __hip_atomic_fetch_add(lcnt + j2, 1u, __ATOMIC_RELAXED, __HIP_MEMORY_SCOPE_WORKGROUP); }
                }
                __syncthreads();
                if (tS < 16) { const unsigned cn = lcnt[tS]; lcnt[16 + tS] = cn ? atomicAdd(ACNT + bh * 16 + tS, cn) : 0u; }
                __syncthreads();
                if (hi == 0) { const unsigned qpos = (unsigned)(bq * 256 + waveS * 32 + r32);
                    if (j0 >= 0) AL[(size_t)(bh * 16 + j0) * att::LCAP + lcnt[16 + j0] + k0] = (unsigned short)(qpos | (1u << 12));
                    if (j1 >= 0) AL[(size_t)(bh * 16 + j1) * att::LCAP + lcnt[16 + j1] + k1] = (unsigned short)(qpos | (2u << 12));
                    if (j2 >= 0) AL[(size_t)(bh * 16 + j2) * att::LCAP + lcnt[16 + j2] + k2] = (unsigned short)(qpos | (3u << 12)); }
                __syncthreads();
            }
        }
        GRID_BAR();
        {
            ROLE_CTX38();
            if (conv_) { CONV_LOOP(F.ctl + CW_DONE, na_, 2); } else {
            LAS int* pre = (LAS int*)(F.lds + TABA_OFF);
            int tA = threadIdx.x; asm volatile("" : "+v"(tA)); const int laneA = tA & 63;
            if (tA < 64) { int c[16]; int sum = 0;
#pragma unroll
                for (int k = 0; k < 16; ++k) { const int cn = (int)__hip_atomic_load(ACNT + laneA * 16 + k, RLX_AGENT); c[k] = (cn + 255) >> 8; sum += c[k]; }
                int inc = sum;
#pragma unroll
                for (int o = 1; o < 64; o <<= 1) { const int t = __shfl_up(inc, o); if (laneA >= o) inc += t; }
                int ex = inc - sum;
#pragma unroll
                for (int k = 0; k < 16; ++k) { pre[laneA * 16 + k] = ex; ex += c[k]; }
                if (laneA == 63) pre[1024] = inc; }
            __syncthreads();
            int NU = __builtin_amdgcn_readfirstlane(pre[1024]); NU = NU < 0 ? 0 : (NU > 7680 ? 7680 : NU);
            const int ub = (int)(((long)av_ * NU * REP_A2) / na_), ue = (int)(((long)(av_ + 1) * NU * REP_A2) / na_);
            if (ub < ue) {
                int li, cc, cnt, nch;
                { int lo_ = 0, hi_ = 1024; const int u0 = ub % NU;
#pragma unroll
                  for (int s_ = 0; s_ < 10; ++s_) { const int mid_ = (lo_ + hi_) >> 1; if (pre[mid_] <= u0) lo_ = mid_; else hi_ = mid_; }
                  li = __builtin_amdgcn_readfirstlane(lo_); cc = u0 - __builtin_amdgcn_readfirstlane(pre[li]); cnt = (int)__builtin_amdgcn_readfirstlane(__hip_atomic_load(ACNT + li, RLX_AGENT)); nch = (cnt + 255) >> 8; }
#define MKC1(r) do { const int bh_ = li >> 4, b_ = bh_ >> 3, h_ = bh_ & 7; (r).qoff = (unsigned)(b_ * SEQ * 1024 + h_ * 128); (r).lbase = (unsigned)(li * att::LCAP + cc * 256); \
                    (r).rows = (cnt - cc * 256) < 256 ? ((cnt - cc * 256) < 1 ? 1 : (cnt - cc * 256)) : 256; (r).pbase = (unsigned)(bh_ * 4096); (r).qpos0 = 0; (r).ns = 0; } while (0)
#define ADV1() do { ++cc; if (cc >= nch) { cc = 0; do { li = (li + 1) & 1023; cnt = (int)__builtin_amdgcn_readfirstlane(__hip_atomic_load(ACNT + li, RLX_AGENT)); nch = (cnt + 255) >> 8; } while (nch == 0); } } while (0)
                att::QState S; att::CRef cur; MKC1(cur);
                { const int wid_ = __builtin_amdgcn_readfirstlane(tA >> 6); att::q_loads2<1>(BS, cur, S, wid_, laneA & 31, laneA >> 5); }
                int resident = -1;
                for (int u = ub; u < ue; ++u) {
                    if (li != resident) { __syncthreads(); att::load_kv(BS, cur.qoff, (li & 15) * 256, (char*)lds + RING_OFF, tA); __syncthreads(); resident = li; }
                    const bool has_next = (u + 1 < ue);
                    att::CRef nxt = cur; if (has_next) { ADV1(); MKC1(nxt); }
                    float mo, lo2; f32x16 oacc[4];
                    att::chunk<1>(BS, cur, nxt, has_next, (char*)lds + RING_OFF, S, tA, mo, lo2, oacc);
                    cur = nxt;
                }
                __syncthreads();
#undef MKC1
#undef ADV1
            }
            ROLE_DONE(0);
            }
        }
        GRID_BAR();
        {
            const int NU = BATCH * NH * 16 * REP_ATT;
            int tB = threadIdx.x; asm volatile("" : "+v"(tB)); const int laneB = tB & 63, widB = __builtin_amdgcn_readfirstlane(tB >> 6);
#define MKC0(r, ko, k0, u_) do { const int uu = (u_) % (BATCH * NH * 16), bh_ = uu >> 4, bq_ = uu & 15, b_ = bh_ >> 3, h_ = bh_ & 7; (ko) = (unsigned)(b_ * SEQ * 1024 + h_ * 128); (k0) = bq_ * 256; \
                (r).qoff = (ko) + (unsigned)(bq_ * 256 * 1024); (r).lbase = 0u; (r).rows = 256; (r).pbase = (unsigned)(bh_ * 4096); (r).qpos0 = bq_ * 256; (r).ns = bq_ < 3 ? bq_ : 3; } while (0)
            ROLE_CTX();
            if (conv_) { CONV_LOOP(F.ctl + CW_DONE + 64, na_, 2); } else {
            if (av_ < NU) {
                att::CRef cur; unsigned koff; int key0; MKC0(cur, koff, key0, av_);
                att::QState S; att::KVRegs R;
                att::q_loads2<0>(BS, cur, S, att::rb0(widB), laneB & 31, laneB >> 5);
                att::load_kv_issue(BS, koff, key0, tB, R);
                for (int u = av_; u < NU; u += na_) {
                    __syncthreads();
                    att::load_kv_commit((char*)lds + RING_OFF, tB, R);
                    __syncthreads();
                    float mo, lo2; f32x16 oacc[4];
                    att::chunk<0>(BS, cur, cur, false, (char*)lds + RING_OFF, S, tB, mo, lo2, oacc);
                    __syncthreads();
                    att::CRef nxt = cur; unsigned nkoff = koff; int nkey0 = key0;
                    if (u + na_ < NU) MKC0(nxt, nkoff, nkey0, u + na_);
                    att::own_finish(BS, cur, (char*)lds + RING_OFF, tB, mo, lo2, oacc, nxt, nkoff, nkey0, S, R);
                    cur = nxt; koff = nkoff; key0 = nkey0;
                }
            }
#undef MKC0
            ROLE_DONE(1);
            }
            __syncthreads();
        }
        __syncthreads();
        {
            const bf16_t* Ub = (const bf16_t*)(ws + WS_U); const bf16_t* VGb = (const bf16_t*)(ws + WS_VG); bf16_t* Gb = (bf16_t*)(ws + WS_GO);
            const bf16_t* SW = (const bf16_t*)(ws + WS_SGUW); const float* sgu_b = KARG_IN(4); const float* ln_g = KARG_IN(5); const float* ln_b = KARG_IN(6);
            constexpr int VTP = 136;
            LAS bf16_t* vT = (LAS bf16_t*)(F.lds + RING_OFF);
            LAS float* stat = (LAS float*)(F.lds + RING_OFF + 128 * VTP * 2);
            int tG = threadIdx.x; asm volatile("" : "+v"(tG)); const int laneG = tG & 63, waveG = __builtin_amdgcn_readfirstlane(tG >> 6), r32 = laneG & 31, hi = laneG >> 5;
            for (int n0 = F.vcu; n0 < (T / SGU_CHUNK) * REP_SGU; n0 += F.G) { const int n = n0 % (T / SGU_CHUNK);
                const size_t t0 = (size_t)n * SGU_CHUNK;
                { u32x4 sa[16], sb[16];
#pragma unroll
                for (int rr = 0; rr < 16; ++rr) { const u32x4* p = (const u32x4*)(VGb + (t0 + waveG * 16 + rr) * 1024) + laneG * 2; sa[rr] = p[0]; sb[rr] = p[1]; }
#pragma unroll
                for (int rr = 0; rr < 16; ++rr) { const int row = waveG * 16 + rr;
                    const u32x4 a = sa[rr], b = sb[rr]; float v[16] = {bf_lo(a.x), bf_hi(a.x), bf_lo(a.y), bf_hi(a.y), bf_lo(a.z), bf_hi(a.z), bf_lo(a.w), bf_hi(a.w), bf_lo(b.x), bf_hi(b.x), bf_lo(b.y), bf_hi(b.y), bf_lo(b.z), bf_hi(b.z), bf_lo(b.w), bf_hi(b.w)};
                    float s = 0.f;
#pragma unroll
                    for (int e = 0; e < 16; ++e) s += v[e];
                    const float mean = wave_sum(s) * (1.f / 1024.f); float q = 0.f;
#pragma unroll
                    for (int e = 0; e < 16; ++e) { const float d = v[e] - mean; q += d * d; }
                    const float rstd = 1.0f / sqrtf(wave_sum(q) * (1.f / 1024.f) + EPS);
                    if (laneG == 0) { stat[row * 2] = mean; stat[row * 2 + 1] = rstd; } } }
                __syncthreads();
                for (int g = 0; g < SGU_G; ++g) {
                    const int tt = waveG >> 1, ct0 = (waveG & 1) * 2;
                    u32x4 vv[4];
#pragma unroll
                    for (int i = 0; i < 4; ++i) { const int q = tG + 512 * i, s_ = q >> 4, cc = (q & 15) * 8; vv[i] = *(const u32x4*)(VGb + (t0 + s_) * 1024 + g * 128 + cc); }
                    const bf16_t* wrow = SW + ((size_t)g * 128 + tt * 32 + r32) * 128 + hi * 8;
                    bf16x8 af[8];
#pragma unroll
                    for (int ks = 0; ks < 8; ++ks) af[ks] = *(const bf16x8*)(wrow + ks * 16);
                    const size_t orow_ = (t0 + tt * 32 + r32) * 1024 + g * 128 + ct0 * 32 + hi * 4;
                    u32x2 uu0[4], uu1[4];
#pragma unroll
                    for (int q = 0; q < 4; ++q) { uu0[q] = *(const u32x2*)(Ub + orow_ + q * 8); uu1[q] = *(const u32x2*)(Ub + orow_ + 32 + q * 8); }
                    const float bias = sgu_b[g * 128 + tt * 32 + r32];
#pragma unroll
                    for (int i = 0; i < 4; ++i) { const int q = tG + 512 * i, s = q >> 4, cc = (q & 15) * 8;
                        const u32x4 v = vv[i];
                        const float mean = stat[s * 2], rstd = stat[s * 2 + 1];
                        const f32x4 g0 = *(const f32x4*)(ln_g + g * 128 + cc), g1 = *(const f32x4*)(ln_g + g * 128 + cc + 4), b0 = *(const f32x4*)(ln_b + g * 128 + cc), b1 = *(const f32x4*)(ln_b + g * 128 + cc + 4);
                        float y[8] = {bf_lo(v.x), bf_hi(v.x), bf_lo(v.y), bf_hi(v.y), bf_lo(v.z), bf_hi(v.z), bf_lo(v.w), bf_hi(v.w)};
#pragma unroll
                        for (int e = 0; e < 8; ++e) { const float gg = e < 4 ? g0[e & 3] : g1[e & 3], bb = e < 4 ? b0[e & 3] : b1[e & 3]; y[e] = (y[e] - mean) * rstd * gg + bb; vT[(cc + e) * VTP + s] = (bf16_t)f2bf(y[e]); } }
                    __syncthreads();
                    f32x16 acc0 = f32x16{}, acc1 = f32x16{};
#pragma unroll
                    for (int ks = 0; ks < 8; ++ks) if (ks < 2 * (tt + 1)) {
                        const bf16x8 b0 = *(const LAS bf16x8*)(vT + (ct0 * 32 + r32) * VTP + ks * 16 + hi * 8);
                        const bf16x8 b1 = *(const LAS bf16x8*)(vT + ((ct0 + 1) * 32 + r32) * VTP + ks * 16 + hi * 8);
                        acc0 = __builtin_amdgcn_mfma_f32_32x32x16_bf16(b0, af[ks], acc0, 0, 0, 0);
                        acc1 = __builtin_amdgcn_mfma_f32_32x32x16_bf16(b1, af[ks], acc1, 0, 0, 0);
                    }
#pragma unroll
                    for (int q = 0; q < 4; ++q) {
                        u32x2 w0, w1;
                        w0.x = cvt_pk_bf16(bf_lo(uu0[q].x) * (acc0[4 * q + 0] + bias), bf_hi(uu0[q].x) * (acc0[4 * q + 1] + bias)); w0.y = cvt_pk_bf16(bf_lo(uu0[q].y) * (acc0[4 * q + 2] + bias), bf_hi(uu0[q].y) * (acc0[4 * q + 3] + bias));
                        w1.x = cvt_pk_bf16(bf_lo(uu1[q].x) * (acc1[4 * q + 0] + bias), bf_hi(uu1[q].x) * (acc1[4 * q + 1] + bias)); w1.y = cvt_pk_bf16(bf_lo(uu1[q].y) * (acc1[4 * q + 2] + bias), bf_hi(uu1[q].y) * (acc1[4 * q + 3] + bias));
                        *(u32x2*)(Gb + orow_ + q * 8) = w0; *(u32x2*)(Gb + orow_ + 32 + q * 8) = w1; }
                    __syncthreads();
                }
            }
        }
        if (BOTH(3)) GRID_BAR();
    }
    if (IN(4)) {
        PH_CTX();
        pg8::DenseOrder S; S.init(ws + WS_AO, ws + WS_WPA8, T, DM, DA / 2, F.G, bx_, ((REP_GEMM >> 4) & 1) + 1);
        EpiGate<false> E{(const bf16_t*)(ws + WS_GA), (bf16_t*)(ws + WS_MG)};
        pg8::gemm_phase<EpiGate<false>, pg8::DenseOrder, true, true, true>(F.lds + RING_OFF, DA / 2, S, E, F.tid);
    }
    if (IN(5)) {
        PH_CTX();
        pg8::DenseOrder S; S.init(ws + WS_GO, ws + WS_WPB, T, DM, DS, F.G, bx_);
        EpiGate<true> E{(const bf16_t*)(ws + WS_GS), (bf16_t*)(ws + WS_MG)};
        pg8::gemm_phase<EpiGate<true>, pg8::DenseOrder, true, true>(F.lds + RING_OFF, DS, S, E, F.tid);
        if (BOTH(5)) GRID_BAR();
    }
    if (IN(6)) {
        PH_CTX();
        pg8::DenseOrder S; S.init(ws + WS_MG, ws + WS_WOUT, T, DM, DM, F.G, bx_, ((REP_GEMM >> 6) & 1) + 1);
        EpiResNorm E{KARG_IN(0), KARG_IN(10), H, ws + WS_H8, (float*)(F.ctl + CW_SS)};
        pg8::gemm_phase<EpiResNorm, pg8::DenseOrder, true, true>(F.lds + RING_OFF, DM, S, E, F.tid);
        if (BOTH(6)) GRID_BAR();
    }
    if (IN(7)) {
        PH_CTX();
        { pg8::DenseOrder S; S.init(H, ws + WS_WR, T, 256, DM, F.G, bx_);
          EpiLogits E{(float*)(ws + WS_LOG)};
          pg8::gemm_phase<EpiLogits, pg8::DenseOrder, false, true>(F.lds + RING_OFF, DM, S, E, F.tid); }
        __syncthreads();
        CONV_LOOP((unsigned*)nullptr, 0, 4);
        if (BOTH(7)) GRID_BAR();
    }
    if (IN(8)) { if (BOTH(8)) {   } }
    if (IN(9)) {
        PH_CTX();
        const float* LG = (const float*)(ws + WS_LOG); const float* brg = KARG_IN(12); const float* bre = KARG_IN(14);
        float* TW = (float*)(ws + WS_TOKW); int* LIST = (int*)(ws + WS_LIST); unsigned* CNT = F.ctl + CW_CNT; const float* SSQ = (const float*)(F.ctl + CW_SS);
        LAS unsigned* lcnt = (LAS unsigned*)(F.lds + RING_OFF);
        for (int base_t = F.vcu * 128; base_t < T; base_t += F.G * 128) {
            if (F.tid < 64) lcnt[F.tid] = 0u;
            __syncthreads();
            const int t = base_t + F.tid; const bool act = F.tid < 128 && t < T;
            int e0 = 0, e1 = 0; unsigned r0 = 0, r1 = 0; float w0 = 0.f, w1 = 0.f, rstd_t = 0.f;
            if (act) {
            const float* lr = LG + (size_t)t * 64; const float rstd = 1.0f / sqrtf(SSQ[t] * (1.f / DM) + EPS); rstd_t = rstd;
            float gl[4];
#pragma unroll
            for (int j = 0; j < 4; ++j) gl[j] = lr[j] * rstd + brg[j];
            float gmax = gl[0]; int grp = 0;
#pragma unroll
            for (int j = 1; j < 4; ++j) { const bool gt = gl[j] > gmax; gmax = gt ? gl[j] : gmax; grp = gt ? j : grp; }
            float gs = 0.f;
#pragma unroll
            for (int j = 0; j < 4; ++j) gs += __expf(gl[j] - gmax);
            const float p_grp = 1.0f / gs;
            float el[8];
#pragma unroll
            for (int j = 0; j < 8; ++j) el[j] = lr[4 + grp * 8 + j] * rstd + bre[grp * 8 + j];
            float b0 = el[0]; int i0 = 0;
#pragma unroll
            for (int j = 1; j < 8; ++j) { const bool gt = el[j] > b0; b0 = gt ? el[j] : b0; i0 = gt ? j : i0; }
            float b1 = -__builtin_inff(); int i1 = 0;
#pragma unroll
            for (int j = 0; j < 8; ++j) { const bool gt = (j != i0) && (el[j] > b1); b1 = gt ? el[j] : b1; i1 = gt ? j : i1; }
            const float d = __expf(b1 - b0);
            w0 = p_grp / (1.0f + d); w1 = p_grp * d / (1.0f + d);
            e0 = grp * 8 + i0; e1 = grp * 8 + i1;
            r0 = __hip_atomic_fetch_add(lcnt + e0, 1u, __ATOMIC_RELAXED, __HIP_MEMORY_SCOPE_WORKGROUP); r1 = __hip_atomic_fetch_add(lcnt + e1, 1u, __ATOMIC_RELAXED, __HIP_MEMORY_SCOPE_WORKGROUP);
            }
            __syncthreads();
            if (F.tid < 32) { const unsigned cn = lcnt[F.tid]; lcnt[32 + F.tid] = cn ? atomicAdd(CNT + 64 * F.tid, cn) : 0u; }
            __syncthreads();
            if (act) { const unsigned p0 = lcnt[32 + e0] + r0, p1 = lcnt[32 + e1] + r1;
                LIST[(size_t)e0 * T + p0] = 2 * t; LIST[(size_t)e1 * T + p1] = 2 * t + 1; TW[2 * t] = w0; TW[2 * t + 1] = w1;
                float* LISTR = (float*)(ws + WS_LISTR); LISTR[(size_t)e0 * T + p0] = rstd_t; LISTR[(size_t)e1 * T + p1] = rstd_t; }
            __syncthreads();
        }
        if (BOTH(9)) GRID_BAR();
    }
    if (IN(10) || IN(11)) {
        PH_CTX();
        LAS int* tab = (LAS int*)(F.lds + TAB_OFF);
        if (F.tid < NE) tab[961 + F.tid] = (int)__hip_atomic_load(F.ctl + CW_CNT + 64 * F.tid, RLX_AGENT);
        __syncthreads();
        if (F.tid == 0) { int nrb = 0;
            for (int e = 0; e < NE; ++e) { const int c = tab[961 + e];
                for (int p = 0; p < c; p += 256) { tab[nrb] = e; tab[320 + nrb] = e * T + p; tab[640 + nrb] = (c - p) < 256 ? (c - p) : 256; ++nrb; } }
            tab[960] = nrb; }
        __syncthreads();
        const int nrb = __builtin_amdgcn_readfirstlane(tab[960]);
        if (IN(10)) {
            MoeOrder<true> S; S.tab = tab; S.nrb = nrb; S.G = F.G; S.vcu = F.vcu; S.A = (const char*)(ws + WS_H8); S.Bt = (const char*)(ws + WS_WGU); S.a_rb_bytes = 0; S.b_e_bytes = (size_t)DM * DM; S.b_pn_bytes = (size_t)256 * DM; S.list = (const int*)(ws + WS_LIST);
            { LAS unsigned* rt = (LAS unsigned*)(F.lds + RING_BYTES);
              S.rowtab = rt;
#pragma unroll 1
              for (int i = 0; i < 9; ++i) { pg8::Unit u; const bool ok = S.next(i, u); if (!ok) break;
                  if (F.tid < 256) { const int r = F.tid; const int a = S.list[u.x0 + (r < u.x1 ? r : 0)]; rt[i * 256 + r] = (unsigned)(a >> 1) * (unsigned)DM; } }
              __syncthreads(); }
            EpiSwiglu E{ws + WS_HID, (const float*)(ws + WS_LISTR)};
            pg8::gemm_phase<EpiSwiglu, MoeOrder<true>, true, true, true>(F.lds + RING_OFF, DM / 2, S, E, F.tid);
            if (BOTH(10)) GRID_BAR();
        }
        if (IN(11)) {
            MoeOrder<false> S; S.tab = tab; S.nrb = nrb; S.G = F.G; S.vcu = F.vcu; S.A = (const char*)(ws + WS_HID); S.Bt = (const char*)(ws + WS_WD); S.a_rb_bytes = (size_t)256 * FF; S.b_e_bytes = (size_t)DM * FF; S.b_pn_bytes = (size_t)256 * FF; S.list = (const int*)(ws + WS_LIST);
            EpiScatter E{(const int*)(ws + WS_LIST), ws + WS_Y};
            pg8::gemm_phase<EpiScatter, MoeOrder<false>, true, true, true>(F.lds + RING_OFF, FF / 2, S, E, F.tid);
            if (BOTH(11)) GRID_BAR();
        }
    }
    if (IN(12)) {
        PH_CTX();
        const unsigned char* Y = ws + WS_Y; const float* TW = (const float*)(ws + WS_TOKW); const f32x4* gf = (const f32x4*)KARG_IN(18) + F.lane; const f32x4* gn = (const f32x4*)KARG_IN(10) + F.lane;
        bool poison = (__hip_atomic_load(F.ctl + CW_TMO, RLX_AGENT) != 0u);
        if (N_LAUNCHES != PER_PHASE) for (int li = 0; li < N_LAUNCHES; ++li) poison |= __hip_atomic_load(F.ctl + CW_BAR + li * XCD_BAR_WORDS + XB_TMO, RLX_AGENT) != 0u;
        f32x4 ign[8], gfin[8];
#pragma unroll
        for (int j = 0; j < 8; ++j) { const f32x4 gg = gn[64 * j]; ign[j] = (f32x4){__builtin_amdgcn_rcpf(gg.x), __builtin_amdgcn_rcpf(gg.y), __builtin_amdgcn_rcpf(gg.z), __builtin_amdgcn_rcpf(gg.w)}; gfin[j] = gf[64 * j]; }
        for (int m0_ = gw; m0_ < T * REP_P12; m0_ += NGW) { const int m = m0_ % T;
            const u32x2* hr = (const u32x2*)(H + (size_t)m * DM) + F.lane; const unsigned* y0 = (const unsigned*)(Y + (size_t)(2 * m) * DM) + F.lane; const unsigned* y1 = (const unsigned*)(Y + (size_t)(2 * m + 1) * DM) + F.lane;
            f32x4* orow = (f32x4*)(F.out + (size_t)m * DM) + F.lane;
            const float w0 = TW[2 * m], w1 = TW[2 * m + 1];
            f32x4 v[8]; float s = 0.f;
#pragma unroll
            for (int j = 0; j < 8; ++j) { const u32x2 hv = __builtin_nontemporal_load(hr + 64 * j); const unsigned a = __builtin_nontemporal_load(y0 + 64 * j), b = __builtin_nontemporal_load(y1 + 64 * j); const f32x4 ig = ign[j];
                const f32x2 a01 = __builtin_amdgcn_cvt_pk_f32_fp8((int)a, false), a23 = __builtin_amdgcn_cvt_pk_f32_fp8((int)a, true), b01 = __builtin_amdgcn_cvt_pk_f32_fp8((int)b, false), b23 = __builtin_amdgcn_cvt_pk_f32_fp8((int)b, true);
                v[j].x = bf_lo(hv.x) * ig.x + w0 * a01[0] + w1 * b01[0]; v[j].y = bf_hi(hv.x) * ig.y + w0 * a01[1] + w1 * b01[1];
                v[j].z = bf_lo(hv.y) * ig.z + w0 * a23[0] + w1 * b23[0]; v[j].w = bf_hi(hv.y) * ig.w + w0 * a23[1] + w1 * b23[1];
                s += (v[j].x * v[j].x + v[j].y * v[j].y) + (v[j].z * v[j].z + v[j].w * v[j].w); }
            const float rstd = 1.0f / sqrtf(wave_sum(s) * (1.f / DM) + EPS);
#pragma unroll
            for (int j = 0; j < 8; ++j) { const f32x4 g = gfin[j]; f32x4 o = v[j] * rstd * g; if (poison) { const float qn = __builtin_nanf(""); o = (f32x4){qn, qn, qn, qn}; } orow[64 * j] = o; }
        }
    }
#undef IN
#undef BOTH
#undef GRID_BAR
}

extern "C" void kernel_launch(void* const* d_in, const int* in_sizes, int n_in, void* d_out, int out_size, void* d_ws, size_t ws_size, hipStream_t stream) {
    static int grid = 0;
    if (grid == 0) {
        if (n_in != 19 || in_sizes[0] != T * DM || out_size != T * DM || ws_size < WS_END) { fprintf(stderr, "kernel_launch: unexpected shapes (n_in %d, in0 %d, out %d, ws %zu < %zu?); nothing launched\n", n_in, n_in > 0 ? in_sizes[0] : -1, out_size, ws_size, (size_t)WS_END); grid = -1; return; }
        int dev = 0, cus = 0, per_cu = 0;
        if (hipGetDevice(&dev) != hipSuccess || hipDeviceGetAttribute(&cus, hipDeviceAttributeMultiprocessorCount, dev) != hipSuccess) { fprintf(stderr, "kernel_launch: device query failed\n"); grid = -1; return; }
        if (hipFuncSetAttribute((const void*)fwd_kernel, hipFuncAttributeMaxDynamicSharedMemorySize, LDS_BYTES) != hipSuccess) { fprintf(stderr, "kernel_launch: hipFuncSetAttribute failed\n"); grid = -1; return; }
        if (hipOccupancyMaxActiveBlocksPerMultiprocessor(&per_cu, (const void*)fwd_kernel, NWAVES * 64, LDS_BYTES) != hipSuccess || per_cu < 1)
            fprintf(stderr, "kernel_launch: note: occupancy query reports %d workgroups per CU\n", per_cu);
        (void)hipGetLastError();
        grid = cus;
    }
    if (grid < 0) return;
    if (hipMemsetAsync((char*)d_ws + WS_CTL, 0, CTL_ZERO_BYTES, stream) != hipSuccess) { fprintf(stderr, "kernel_launch: memset failed\n"); return; }
    Args a{};
    for (int i = 0; i < 19; ++i) a.in[i] = (const float*)d_in[i];
    a.out = (float*)d_out; a.ws = (unsigned char*)d_ws;
    static_assert(N_LAUNCHES == 1 || N_LAUNCHES == PER_PHASE, "MK_N_LAUNCHES: 1 or 13");
    for (int li = 0; li < N_LAUNCHES; ++li) {
        a.ph_lo = (N_LAUNCHES == PER_PHASE) ? li : 0; a.ph_hi = (N_LAUNCHES == PER_PHASE) ? li + 1 : PER_PHASE; a.li = (N_LAUNCHES == PER_PHASE) ? 0 : li;
        hipLaunchKernelGGL(fwd_kernel, dim3(grid), dim3(NWAVES * 64), LDS_BYTES, stream, a);
        const hipError_t le = hipPeekAtLastError();
        if (le != hipSuccess) { fprintf(stderr, "kernel_launch: launch %d failed: %s\n", li, hipGetErrorName(le)); break; }
    }
}
```
